# Optimizing an MI355X kernel written in HIP

```python
import math
import jax, jax.numpy as jnp
from jax import lax
import numpy as np


D_MODEL = 1024
BATCH = 2
SEQ = 8192
DEPTH = 2

CHUNK = 64
N_EVEN = (DEPTH + 1) // 2
N_ODD = DEPTH // 2
CONV_W = 4
NORM_EPS = 1e-6
F32 = jnp.float32

W_MIX = D_MODEL
W_A = D_MODEL // 2
NH_A = 8
HW_A = W_A // NH_A
RG_C = 8.0
NH_B = 4
DK_B = 64
DV_B = 128
K_B = NH_B * DK_B
V_B = NH_B * DV_B
R_GATE = 16
GATE_NORM = 16.0
P_AB = 2 * W_A + 2 * K_B + 2 * V_B + R_GATE

NH_C = 8
DH_C = 128
W_C = NH_C * DH_C
P_C = 4 * W_C + 2 * NH_C

N_GROUPS = 4
EXP_PER_GROUP = 8
N_EXPERTS = N_GROUPS * EXP_PER_GROUP
TOP_K = 2
D_EXPERT = 512
ROW_BLOCK = 128

kernel_name = 'hybrid_rglru_gla_gdn_hmoe_adaln'


def _offsets(sizes):
    out, acc = [], 0
    for s in sizes[:-1]:
        acc += s
        out.append(acc)
    return out


def rms_norm(x, g):
    x32 = x.astype(F32)
    y = x32 * lax.rsqrt(jnp.mean(x32 * x32, axis=-1, keepdims=True) + NORM_EPS)
    return (y * g.astype(F32)).astype(x.dtype)


def head_rms_norm(o, g):
    return o * lax.rsqrt(jnp.mean(o * o, axis=-1, keepdims=True) + NORM_EPS) * g.astype(F32)


def l2_norm(x):
    return x * lax.rsqrt(jnp.sum(x * x, axis=-1, keepdims=True) + NORM_EPS)


def causal_conv(x, w):
    return lax.conv_general_dilated(
        x, w[:, None, :].astype(x.dtype), window_strides=(1,), padding=[(CONV_W - 1, 0)],
        dimension_numbers=('NWC', 'WIO', 'NWC'), feature_group_count=x.shape[-1])


def to_chunks(t):
    B, S, H = t.shape[:3]
    t = t.reshape((B, S // CHUNK, CHUNK, H) + t.shape[3:])
    return jnp.moveaxis(t, (1, 3), (0, 2))


def from_chunks(t):
    t = jnp.moveaxis(t, (0, 2), (1, 3))
    B, N, C, H = t.shape[:4]
    return t.reshape((B, N * C, H) + t.shape[4:])


def _linear_recurrence_combine(left, right):
    a_l, b_l = left
    a_r, b_r = right
    return a_l * a_r, a_r * b_l + b_r


def rg_lru(x, wa, ba, wx, bx, lam):
    B, S, _ = x.shape
    xh = x.reshape(B, S, NH_A, HW_A)
    r = jax.nn.sigmoid((jnp.einsum('bshi,hij->bshj', xh, wa).reshape(B, S, W_A) + ba).astype(F32))
    i = jax.nn.sigmoid((jnp.einsum('bshi,hij->bshj', xh, wx).reshape(B, S, W_A) + bx).astype(F32))
    log_a = -RG_C * r * jax.nn.softplus(-lam.astype(F32))
    a = jnp.exp(log_a)
    b = jnp.sqrt(-jnp.expm1(2.0 * log_a)) * (i * x.astype(F32))
    _, h = lax.associative_scan(_linear_recurrence_combine, (a, b), axis=1)
    return h


def gla_chunked(q, k, v, lg):
    B, H = q.shape[0], q.shape[2]
    qc, kc, vc = to_chunks(q), to_chunks(k), to_chunks(v)
    gcum = jnp.cumsum(to_chunks(lg), axis=3)
    causal = jnp.tril(jnp.ones((CHUNK, CHUNK), dtype=bool))

    def step(state, inp):
        qb, kb, vb, gb = inp
        g_last = gb[:, :, -1:, :]
        o_inter = jnp.einsum('bhcd,bhde->bhce', qb * jnp.exp(gb), state)
        diff = jnp.where(causal[:, :, None], gb[:, :, :, None, :] - gb[:, :, None, :, :], -jnp.inf)
        att = jnp.einsum('bhid,bhjd,bhijd->bhij', qb, kb, jnp.exp(diff))
        o = o_inter + jnp.einsum('bhij,bhje->bhie', att, vb)
        state = state * jnp.exp(g_last[:, :, 0, :, None]) + jnp.einsum(
            'bhcd,bhce->bhde', kb * jnp.exp(g_last - gb), vb)
        return state, o

    s0 = jnp.zeros((B, H, DK_B, DV_B), F32)
    _, o = lax.scan(step, s0, (qc, kc, vc, gcum))
    return from_chunks(o)


def gated_delta_chunked(q, k, v, beta, g):
    B, H, DV = q.shape[0], q.shape[2], v.shape[-1]
    qc, kc, vc = to_chunks(q), to_chunks(k), to_chunks(v)
    bc = to_chunks(beta)
    gcum = jnp.cumsum(to_chunks(g), axis=-1)
    idx = jnp.arange(CHUNK)
    incl = idx[:, None] >= idx[None, :]
    strict = idx[:, None] > idx[None, :]
    decay = jnp.exp(jnp.where(incl, gcum[..., :, None] - gcum[..., None, :], -jnp.inf))
    k_beta = kc * bc[..., None]
    lower = jnp.where(strict, jnp.einsum('...id,...jd->...ij', k_beta, kc) * decay, 0.0)
    rhs = jnp.concatenate([vc * bc[..., None], k_beta * jnp.exp(gcum)[..., None]], axis=-1)
    sol = lax.linalg.triangular_solve(lower, rhs, left_side=True, lower=True, unit_diagonal=True)
    u_c, w_c = sol[..., :DV], sol[..., DV:]

    def step(state, inp):
        qb, kb, gb, ub, wb, db = inp
        v_new = ub - jnp.einsum('bhck,bhkv->bhcv', wb, state)
        att = jnp.einsum('bhik,bhjk->bhij', qb, kb) * db
        o = jnp.einsum('bhck,bhkv->bhcv', qb * jnp.exp(gb)[..., None], state) + jnp.einsum(
            'bhij,bhjv->bhiv', att, v_new)
        g_last = gb[..., -1:]
        state = state * jnp.exp(g_last)[..., None] + jnp.einsum(
            'bhck,bhcv->bhkv', kb * jnp.exp(g_last - gb)[..., None], v_new)
        return state, o

    s0 = jnp.zeros((B, H, q.shape[-1], DV), F32)
    _, o = lax.scan(step, s0, (qc, kc, gcum, u_c, w_c, decay))
    return from_chunks(o)


def mixer_ab(u, w_in, conv_w, conv_b, rg_wa, rg_ba, rg_wx, rg_bx, rg_lam, gla_wg2, gla_bg2, gla_norm, w_out):
    B, S, _ = u.shape
    xa, ga, q, k, v, og, gl = jnp.split(
        u @ w_in, _offsets([W_A, W_A, K_B, K_B, V_B, V_B, R_GATE]), axis=-1)
    xa = causal_conv(xa, conv_w) + conv_b
    ya = jax.nn.gelu(ga.astype(F32)) * rg_lru(xa, rg_wa, rg_ba, rg_wx, rg_bx, rg_lam)
    q = q.astype(F32).reshape(B, S, NH_B, DK_B) * DK_B ** -0.5
    k = k.astype(F32).reshape(B, S, NH_B, DK_B)
    v = v.astype(F32).reshape(B, S, NH_B, DV_B)
    lg = jax.nn.log_sigmoid((gl @ gla_wg2 + gla_bg2).astype(F32)).reshape(B, S, NH_B, DK_B) / GATE_NORM
    ob = head_rms_norm(gla_chunked(q, k, v, lg), gla_norm) * jax.nn.silu(og.astype(F32)).reshape(B, S, NH_B, DV_B)
    y = jnp.concatenate([ya, ob.reshape(B, S, V_B)], axis=-1).astype(u.dtype)
    return y @ w_out


def mixer_c(u, w_in, conv_w, a_log, dt_bias, norm_g, w_out):
    B, S, _ = u.shape
    qkv, z, b_logit, a_logit = jnp.split(u @ w_in, _offsets([3 * W_C, W_C, NH_C, NH_C]), axis=-1)
    qkv = jax.nn.silu(causal_conv(qkv, conv_w).astype(F32))
    q, k, v = jnp.split(qkv, 3, axis=-1)
    q = l2_norm(q.reshape(B, S, NH_C, DH_C)) * DH_C ** -0.5
    k = l2_norm(k.reshape(B, S, NH_C, DH_C))
    v = v.reshape(B, S, NH_C, DH_C)
    beta = jax.nn.sigmoid(b_logit.astype(F32))
    g = -jnp.exp(a_log.astype(F32)) * jax.nn.softplus(a_logit.astype(F32) + dt_bias.astype(F32))
    o = gated_delta_chunked(q, k, v, beta, g)
    o = head_rms_norm(o, norm_g) * jax.nn.silu(z.astype(F32)).reshape(B, S, NH_C, DH_C)
    return o.reshape(B, S, W_C).astype(u.dtype) @ w_out


def hier_moe(u, w_grp, b_grp, w_rt, b_rt, w1, w3, w2):
    B, S, D = u.shape
    T = B * S
    TK = T * TOP_K
    xt = u.reshape(T, D)
    pg = jax.nn.softmax((xt @ w_grp + b_grp).astype(F32), axis=-1)
    pg_top, g_idx = lax.top_k(pg, 1)
    le = (xt @ w_rt + b_rt).astype(F32).reshape(T, N_GROUPS, EXP_PER_GROUP)
    le = jnp.einsum('tge,tg->te', le, jax.nn.one_hot(g_idx[:, 0], N_GROUPS, dtype=F32))
    pe_top, e_idx = lax.top_k(jax.nn.softmax(le, axis=-1), TOP_K)
    w_tok = pg_top * pe_top / jnp.sum(pe_top, axis=-1, keepdims=True)
    eid = (g_idx * EXP_PER_GROUP + e_idx).reshape(TK)
    tok = jnp.repeat(jnp.arange(T, dtype=jnp.int32), TOP_K)
    wts = w_tok.reshape(TK)
    order = jnp.argsort(eid)
    se = eid[order]
    counts = jnp.bincount(eid, length=N_EXPERTS)
    padded = (counts + ROW_BLOCK - 1) // ROW_BLOCK * ROW_BLOCK
    start_s = jnp.cumsum(counts) - counts
    end_p = jnp.cumsum(padded)
    start_p = end_p - padded
    dest = start_p[se] + jnp.arange(TK) - start_s[se]
    n_blocks = (TK + ROW_BLOCK - 1) // ROW_BLOCK + N_EXPERTS
    n_rows = n_blocks * ROW_BLOCK
    buf_tok = jnp.full((n_rows,), T, jnp.int32).at[dest].set(tok[order])
    buf_w = jnp.zeros((n_rows,), F32).at[dest].set(wts[order])
    blk_e = jnp.minimum(
        jnp.sum(jnp.arange(n_blocks)[:, None] * ROW_BLOCK >= end_p[None, :], axis=1), N_EXPERTS - 1)
    xpad = jnp.concatenate([xt, jnp.zeros((1, D), xt.dtype)], axis=0)
    xb = xpad[buf_tok].reshape(n_blocks, ROW_BLOCK, D)

    def expert_block(args):
        xr, e = args
        return (jax.nn.silu(xr @ w1[e]) * (xr @ w3[e])) @ w2[e]

    yb = lax.map(expert_block, (xb, blk_e))
    y = jnp.zeros((T + 1, D), F32).at[buf_tok].add(yb.reshape(n_rows, D).astype(F32) * buf_w[:, None])
    return y[:T].reshape(B, S, D).astype(u.dtype)


def setup_inputs(seed: int = 0) -> dict:
    key = jax.random.key(seed)
    k = jax.random.split(key, 40)
    D = D_MODEL

    def nrm(i, shape, scale):
        return jax.random.normal(k[i], shape, jnp.float32) * scale

    def unif(i, shape, lo, hi):
        return jax.random.uniform(k[i], shape, jnp.float32, lo, hi)

    a_rg = unif(13, (N_EVEN, W_A), 0.9, 0.999) ** (1.0 / RG_C)
    dt = jnp.exp(unif(21, (N_ODD, NH_C), math.log(1e-3), math.log(1e-1)))
    return {
        'x': nrm(0, (BATCH, SEQ, D), 1.0),
        'c': nrm(1, (BATCH, D), 1.0),
        'norm1': 1.0 + nrm(2, (DEPTH, D), 0.02),
        'norm2': 1.0 + nrm(3, (DEPTH, D), 0.02),
        'w_ada': nrm(4, (DEPTH, D, 6 * D), 0.5 * D ** -0.5),
        'b_ada': nrm(5, (DEPTH, 6 * D), 0.02),
        'w_in_ab': nrm(6, (N_EVEN, D, P_AB), D ** -0.5),
        'conv_a_w': nrm(7, (N_EVEN, CONV_W, W_A), CONV_W ** -0.5),
        'conv_a_b': nrm(8, (N_EVEN, W_A), 0.02),
        'rg_wa': nrm(9, (N_EVEN, NH_A, HW_A, HW_A), HW_A ** -0.5),
        'rg_ba': nrm(10, (N_EVEN, W_A), 0.02),
        'rg_wx': nrm(11, (N_EVEN, NH_A, HW_A, HW_A), HW_A ** -0.5),
        'rg_bx': nrm(12, (N_EVEN, W_A), 0.02),
        'rg_lam': jnp.log(a_rg) - jnp.log1p(-a_rg),
        'gla_wg2': nrm(14, (N_EVEN, R_GATE, K_B), R_GATE ** -0.5),
        'gla_bg2': nrm(15, (N_EVEN, K_B), 0.02),
        'gla_norm': 1.0 + nrm(16, (N_EVEN, DV_B), 0.02),
        'w_out_ab': nrm(17, (N_EVEN, W_MIX, D), W_MIX ** -0.5),
        'w_in_c': nrm(18, (N_ODD, D, P_C), D ** -0.5),
        'conv_c_w': nrm(19, (N_ODD, CONV_W, 3 * W_C), CONV_W ** -0.5),
        'dn_a_log': jnp.log(unif(20, (N_ODD, NH_C), 1.0, 16.0)),
        'dn_dt_bias': dt + jnp.log(-jnp.expm1(-dt)),
        'dn_norm': 1.0 + nrm(22, (N_ODD, DH_C), 0.02),
        'w_out_c': nrm(23, (N_ODD, W_C, D), W_C ** -0.5),
        'moe_w_grp': nrm(24, (DEPTH, D, N_GROUPS), D ** -0.5),
        'moe_b_grp': nrm(25, (DEPTH, N_GROUPS), 0.01),
        'moe_w_rt': nrm(26, (DEPTH, D, N_EXPERTS), D ** -0.5),
        'moe_b_rt': nrm(27, (DEPTH, N_EXPERTS), 0.01),
        'moe_w1': nrm(28, (DEPTH, N_EXPERTS, D, D_EXPERT), D ** -0.5),
        'moe_w3': nrm(29, (DEPTH, N_EXPERTS, D, D_EXPERT), D ** -0.5),
        'moe_w2': nrm(30, (DEPTH, N_EXPERTS, D_EXPERT, D), D_EXPERT ** -0.5),
        'final_norm': 1.0 + nrm(31, (D,), 0.02),
    }


def reference(x, c, norm1, norm2, w_ada, b_ada, w_in_ab, conv_a_w, conv_a_b, rg_wa, rg_ba, rg_wx, rg_bx,
              rg_lam, gla_wg2, gla_bg2, gla_norm, w_out_ab, w_in_c, conv_c_w, dn_a_log, dn_dt_bias, dn_norm,
              w_out_c, moe_w_grp, moe_b_grp, moe_w_rt, moe_b_rt, moe_w1, moe_w3, moe_w2, final_norm):
    cond = jax.nn.silu(c)
    h = x
    for layer in range(DEPTH):
        mod = cond @ w_ada[layer] + b_ada[layer]
        sh1, sc1, gt1, sh2, sc2, gt2 = jnp.split(mod[:, None, :], 6, axis=-1)
        u = rms_norm(h, norm1[layer]) * (1.0 + sc1) + sh1
        j = layer // 2
        if layer % 2 == 0:
            m = mixer_ab(u, w_in_ab[j], conv_a_w[j], conv_a_b[j], rg_wa[j], rg_ba[j], rg_wx[j], rg_bx[j],
                         rg_lam[j], gla_wg2[j], gla_bg2[j], gla_norm[j], w_out_ab[j])
        else:
            m = mixer_c(u, w_in_c[j], conv_c_w[j], dn_a_log[j], dn_dt_bias[j], dn_norm[j], w_out_c[j])
        h = h + gt1 * m
        u = rms_norm(h, norm2[layer]) * (1.0 + sc2) + sh2
        h = h + gt2 * hier_moe(u, moe_w_grp[layer], moe_b_grp[layer], moe_w_rt[layer], moe_b_rt[layer],
                               moe_w1[layer], moe_w3[layer], moe_w2[layer])
    return rms_norm(h, final_norm)
```

```cpp
#include <hip/hip_runtime.h>
#include <cstdio>
#include <cstdint>

constexpr int T_ = 16384, D_ = 1024, S_ = 8192;
constexpr int PAB = 2576, PC = 4112;
constexpr float EPS = 1e-6f;

__device__ __forceinline__ float sigmoidf_(float x) { return 1.f / (1.f + __expf(-x)); }
__device__ __forceinline__ float siluf_(float x) { return x / (1.f + __expf(-x)); }
__device__ __forceinline__ float softplusf_(float x) { return x > 20.f ? x : log1pf(__expf(x)); }
__device__ __forceinline__ float gelu_tanh(float x) { return 0.5f * x * (1.f + tanhf(0.7978845608028654f * (x + 0.044715f * x * x * x))); }
__device__ __forceinline__ float wave_sum(float v) {
#pragma unroll
  for (int o = 32; o > 0; o >>= 1) v += __shfl_xor(v, o);
  return v;
}

__global__ __launch_bounds__(256) void k_mod(const float* c, const float* w_ada, const float* b_ada, float* mod, int* cnt) {
  __shared__ float cs[2048];
  for (int i = threadIdx.x; i < 2048; i += 256) cs[i] = siluf_(c[i]);
  if (blockIdx.x == 0 && threadIdx.x < 64) cnt[threadIdx.x] = 0;
  __syncthreads();
  int idx = blockIdx.x * 256 + threadIdx.x;
  int l = idx / 6144, n = idx % 6144;
  float a0 = 0.f, a1 = 0.f;
  const float* w = w_ada + (size_t)l * 1024 * 6144 + n;
  for (int k = 0; k < 1024; ++k) { float wv = w[(size_t)k * 6144]; a0 += cs[k] * wv; a1 += cs[1024 + k] * wv; }
  float bb = b_ada[l * 6144 + n];
  mod[(l * 2 + 0) * 6144 + n] = a0 + bb;
  mod[(l * 2 + 1) * 6144 + n] = a1 + bb;
}

__global__ __launch_bounds__(256) void k_norm_mod(const float* h, const float* g, const float* modl, int sh_part, int sc_part, float* out) {
  int row = blockIdx.x * 4 + (threadIdx.x >> 6), lane = threadIdx.x & 63;
  int b = row / S_;
  const float* hr = h + (size_t)row * D_;
  float v[16]; float ss = 0.f;
#pragma unroll
  for (int j = 0; j < 4; ++j) { float4 x = *(const float4*)(hr + lane * 4 + 256 * j); v[4*j] = x.x; v[4*j+1] = x.y; v[4*j+2] = x.z; v[4*j+3] = x.w; ss += x.x*x.x + x.y*x.y + x.z*x.z + x.w*x.w; }
  ss = wave_sum(ss);
  float rstd = rsqrtf(ss * (1.f / D_) + EPS);
#pragma unroll
  for (int j = 0; j < 4; ++j)
#pragma unroll
    for (int i = 0; i < 4; ++i) {
      int k = lane * 4 + 256 * j + i;
      float y = v[4*j+i] * rstd * g[k];
      if (sc_part >= 0) y = y * (1.f + modl[b * 6144 + sc_part * 1024 + k]) + modl[b * 6144 + sh_part * 1024 + k];
      out[(size_t)row * D_ + k] = y;
    }
}

template <int EPI>
__global__ __launch_bounds__(256) void k_gemm(const float* A, int lda, const float* B, int ldb, float* C, int ldc, int M, int N, int K, const float* res, const float* gate) {
  __shared__ float As[16][68];
  __shared__ float Bs[16][68];
  int tid = threadIdx.x, tx = tid & 15, ty = tid >> 4;
  int m0 = blockIdx.y * 64, n0 = blockIdx.x * 64;
  float acc[4][4] = {};
  for (int k0 = 0; k0 < K; k0 += 16) {
    { int r = tid >> 2, kk = (tid & 3) * 4; float4 a = *(const float4*)(A + (size_t)(m0 + r) * lda + k0 + kk); As[kk][r] = a.x; As[kk+1][r] = a.y; As[kk+2][r] = a.z; As[kk+3][r] = a.w; }
    { int kk = tid >> 4, n = (tid & 15) * 4; float4 bv = make_float4(0.f, 0.f, 0.f, 0.f); if (n0 + n < N) bv = *(const float4*)(B + (size_t)(k0 + kk) * ldb + n0 + n); *(float4*)&Bs[kk][n] = bv; }
    __syncthreads();
#pragma unroll
    for (int kk = 0; kk < 16; ++kk) {
      float4 a = *(const float4*)&As[kk][ty * 4]; float4 bv = *(const float4*)&Bs[kk][tx * 4];
      float av[4] = {a.x, a.y, a.z, a.w}, bw[4] = {bv.x, bv.y, bv.z, bv.w};
#pragma unroll
      for (int i = 0; i < 4; ++i)
#pragma unroll
        for (int j = 0; j < 4; ++j) acc[i][j] += av[i] * bw[j];
    }
    __syncthreads();
  }
#pragma unroll
  for (int i = 0; i < 4; ++i) {
    int r = m0 + ty * 4 + i; int b = r / S_;
#pragma unroll
    for (int j = 0; j < 4; ++j) {
      int n = n0 + tx * 4 + j; if (n >= N) continue;
      float v = acc[i][j];
      if (EPI == 1) v = res[(size_t)r * ldc + n] + gate[b * 6144 + n] * v;
      C[(size_t)r * ldc + n] = v;
    }
  }
}

__global__ __launch_bounds__(512) void k_rg_gates(const float* P, const float* conv_w, const float* conv_b, const float* wa, const float* ba, const float* wx, const float* bx, const float* lam, float* Aout, float* Bout) {
  __shared__ float xc[512];
  int t = blockIdx.x, ch = threadIdx.x, tl = t % S_;
  float v = conv_b[ch];
#pragma unroll
  for (int j = 0; j < 4; ++j) { int tt = tl - 3 + j; if (tt >= 0) v += conv_w[j * 512 + ch] * P[(size_t)(t - 3 + j) * PAB + ch]; }
  xc[ch] = v;
  __syncthreads();
  int h = ch >> 6, jj = ch & 63;
  float r = ba[ch], ii = bx[ch];
  const float* wap = wa + h * 4096 + jj; const float* wxp = wx + h * 4096 + jj;
  for (int i = 0; i < 64; ++i) { float x = xc[h * 64 + i]; r += x * wap[i * 64]; ii += x * wxp[i * 64]; }
  r = sigmoidf_(r); ii = sigmoidf_(ii);
  float log_a = -8.f * r * softplusf_(-lam[ch]);
  float a = __expf(log_a);
  float bb = sqrtf(-expm1f(2.f * log_a)) * (ii * v);
  Aout[(size_t)t * 512 + ch] = a; Bout[(size_t)t * 512 + ch] = bb;
}
__global__ __launch_bounds__(64) void k_rg_scan(const float* Ain, const float* Bin, const float* P, float* Y) {
  int idx = blockIdx.x * 64 + threadIdx.x; int b = idx >> 9, ch = idx & 511;
  float h = 0.f;
  size_t t0 = (size_t)b * S_;
#pragma unroll 8
  for (int t = 0; t < S_; ++t) {
    float a = Ain[(t0 + t) * 512 + ch], bb = Bin[(t0 + t) * 512 + ch], ga = P[(t0 + t) * PAB + 512 + ch];
    h = a * h + bb;
    Y[(t0 + t) * D_ + ch] = gelu_tanh(ga) * h;
  }
}
__global__ __launch_bounds__(256) void k_gla_lg(const float* P, const float* wg2, const float* bg2, float* LG) {
  int t = blockIdx.x, n = threadIdx.x;
  float v = bg2[n];
#pragma unroll
  for (int r = 0; r < 16; ++r) v += P[(size_t)t * PAB + 2560 + r] * wg2[r * 256 + n];
  float ls = fminf(v, 0.f) - log1pf(__expf(-fabsf(v)));
  LG[(size_t)t * 256 + n] = ls * (1.f / 16.f);
}
__global__ __launch_bounds__(128) void k_gla_rec(const float* P, const float* LG, float* O) {
  int b = blockIdx.x >> 2, h = blockIdx.x & 3, j = threadIdx.x;
  float s[64];
#pragma unroll
  for (int d = 0; d < 64; ++d) s[d] = 0.f;
  for (int t = 0; t < S_; ++t) {
    size_t row = (size_t)b * S_ + t;
    const float* q = P + row * PAB + 1024 + h * 64;
    const float* k = P + row * PAB + 1280 + h * 64;
    const float* lg = LG + row * 256 + h * 64;
    float v = P[row * PAB + 1536 + h * 128 + j];
    float o = 0.f;
#pragma unroll
    for (int d = 0; d < 64; ++d) { s[d] = __expf(lg[d]) * s[d] + k[d] * v; o += q[d] * s[d]; }
    O[row * 512 + h * 128 + j] = o * 0.125f;
  }
}
__global__ __launch_bounds__(256) void k_head_norm_gate(const float* O, int ldo, const float* g, const float* Pgate, int ldp, int gate_off, float* Y, int y_off, int nheads) {
  int w = blockIdx.x * 4 + (threadIdx.x >> 6), lane = threadIdx.x & 63;
  int t = w / nheads, h = w % nheads;
  float o0 = O[(size_t)t * ldo + h * 128 + lane], o1 = O[(size_t)t * ldo + h * 128 + 64 + lane];
  float ss = wave_sum(o0 * o0 + o1 * o1);
  float r = rsqrtf(ss * (1.f / 128.f) + EPS);
  float g0 = Pgate[(size_t)t * ldp + gate_off + h * 128 + lane], g1 = Pgate[(size_t)t * ldp + gate_off + h * 128 + 64 + lane];
  Y[(size_t)t * D_ + y_off + h * 128 + lane] = o0 * r * g[lane] * siluf_(g0);
  Y[(size_t)t * D_ + y_off + h * 128 + 64 + lane] = o1 * r * g[64 + lane] * siluf_(g1);
}

__global__ __launch_bounds__(256) void k_dn_prep(const float* P, const float* conv_w, const float* a_log, const float* dt_bias, float* QN, float* KN, float* V, float* BETA, float* G) {
  __shared__ float buf[3072];
  int t = blockIdx.x, tid = threadIdx.x, tl = t % S_;
  for (int c = tid; c < 3072; c += 256) {
    float v = 0.f;
#pragma unroll
    for (int j = 0; j < 4; ++j) { int tt = tl - 3 + j; if (tt >= 0) v += conv_w[j * 3072 + c] * P[(size_t)(t - 3 + j) * PC + c]; }
    buf[c] = siluf_(v);
  }
  __syncthreads();
  int w = tid >> 6, lane = tid & 63;
  for (int gi = w * 4; gi < w * 4 + 4; ++gi) {
    float x0 = buf[gi * 128 + lane], x1 = buf[gi * 128 + 64 + lane];
    float ss = wave_sum(x0 * x0 + x1 * x1);
    float sc = rsqrtf(ss + EPS);
    if (gi < 8) { sc *= 0.08838834764831845f; QN[(size_t)t * D_ + gi * 128 + lane] = x0 * sc; QN[(size_t)t * D_ + gi * 128 + 64 + lane] = x1 * sc; }
    else { int c = (gi - 8) * 128; KN[(size_t)t * D_ + c + lane] = x0 * sc; KN[(size_t)t * D_ + c + 64 + lane] = x1 * sc; }
  }
  for (int c = tid; c < 1024; c += 256) V[(size_t)t * D_ + c] = buf[2048 + c];
  if (tid < 8) {
    BETA[t * 8 + tid] = sigmoidf_(P[(size_t)t * PC + 4096 + tid]);
    G[t * 8 + tid] = -__expf(a_log[tid]) * softplusf_(P[(size_t)t * PC + 4104 + tid] + dt_bias[tid]);
  }
}
__global__ __launch_bounds__(128) void k_dn_rec(const float* QN, const float* KN, const float* V, const float* BETA, const float* G, float* O) {
  int b = blockIdx.x >> 3, h = blockIdx.x & 7, j = threadIdx.x;
  float s[128];
#pragma unroll
  for (int d = 0; d < 128; ++d) s[d] = 0.f;
  for (int t = 0; t < S_; ++t) {
    size_t row = (size_t)b * S_ + t;
    const float* q = QN + row * D_ + h * 128;
    const float* k = KN + row * D_ + h * 128;
    float v = V[row * D_ + h * 128 + j];
    float dec = __expf(G[row * 8 + h]), beta = BETA[row * 8 + h];
    float kd = 0.f;
#pragma unroll
    for (int d = 0; d < 128; ++d) { s[d] *= dec; kd += k[d] * s[d]; }
    float vn = beta * (v - kd);
    float o = 0.f;
#pragma unroll
    for (int d = 0; d < 128; ++d) { s[d] += k[d] * vn; o += q[d] * s[d]; }
    O[row * D_ + h * 128 + j] = o;
  }
}

__global__ __launch_bounds__(64) void k_router(const float* XN, const float* w_grp, const float* b_grp, const float* w_rt, const float* b_rt, int* cnt, int* list, int* tok_e, int* tok_slot, float* tok_w) {
  __shared__ float lg[36];
  int t = blockIdx.x, lane = threadIdx.x;
  const float* x = XN + (size_t)t * D_;
  if (lane < 36) {
    float acc = 0.f;
    if (lane < 4) { for (int k = 0; k < 1024; ++k) acc += x[k] * w_grp[k * 4 + lane]; acc += b_grp[lane]; }
    else { int n = lane - 4; for (int k = 0; k < 1024; ++k) acc += x[k] * w_rt[k * 32 + n]; acc += b_rt[n]; }
    lg[lane] = acc;
  }
  __syncthreads();
  if (lane == 0) {
    int gi = 0; float gm = lg[0];
    for (int i = 1; i < 4; ++i) if (lg[i] > gm) { gm = lg[i]; gi = i; }
    float se = 0.f; for (int i = 0; i < 4; ++i) se += __expf(lg[i] - gm);
    float pg = 1.f / se;
    const float* le = lg + 4 + gi * 8;
    int e0 = 0; float m0 = le[0];
    for (int i = 1; i < 8; ++i) if (le[i] > m0) { m0 = le[i]; e0 = i; }
    int e1 = -1; float m1 = -3.4e38f;
    for (int i = 0; i < 8; ++i) if (i != e0 && le[i] > m1) { m1 = le[i]; e1 = i; }
    float p1 = __expf(m1 - m0);
    float w0 = pg / (1.f + p1), w1 = pg * p1 / (1.f + p1);
    int E0 = gi * 8 + e0, E1 = gi * 8 + e1;
    int s0 = atomicAdd(&cnt[E0], 1), s1 = atomicAdd(&cnt[E1], 1);
    list[E0 * T_ + s0] = t; list[E1 * T_ + s1] = t;
    tok_e[t * 2] = E0; tok_e[t * 2 + 1] = E1; tok_slot[t * 2] = s0; tok_slot[t * 2 + 1] = s1; tok_w[t * 2] = w0; tok_w[t * 2 + 1] = w1;
  }
}
__global__ void k_moe_base(const int* cnt, int* base) {
  if (threadIdx.x == 0) { int acc = 0; for (int e = 0; e < 32; ++e) { base[e] = acc; acc += cnt[e]; } }
}
template <int MODE>
__global__ __launch_bounds__(256) void k_moe_gemm(const float* A, const float* W1, const float* W3, float* C, const int* cnt, const int* base, const int* list) {
  constexpr int K = MODE == 1 ? 1024 : 512, N = MODE == 1 ? 512 : 1024;
  int e = blockIdx.z, m0 = blockIdx.y * 64, n0 = blockIdx.x * 64;
  int ce = cnt[e]; if (m0 >= ce) return;
  int be = base[e];
  __shared__ float As[16][68];
  __shared__ float Bs[16][68];
  __shared__ float Bs3[MODE == 1 ? 16 : 1][68];
  int tid = threadIdx.x, tx = tid & 15, ty = tid >> 4;
  const float* w1 = W1 + (size_t)e * K * N; const float* w3 = MODE == 1 ? W3 + (size_t)e * K * N : nullptr;
  int ar = tid >> 2; bool av = (m0 + ar) < ce;
  const float* arow = nullptr;
  if (av) arow = MODE == 1 ? A + (size_t)list[e * T_ + m0 + ar] * 1024 : A + (size_t)(be + m0 + ar) * 512;
  float acc[4][4] = {}, acc3[4][4] = {};
  for (int k0 = 0; k0 < K; k0 += 16) {
    { int kk = (tid & 3) * 4; float4 a = make_float4(0.f, 0.f, 0.f, 0.f); if (av) a = *(const float4*)(arow + k0 + kk); As[kk][ar] = a.x; As[kk+1][ar] = a.y; As[kk+2][ar] = a.z; As[kk+3][ar] = a.w; }
    { int kk = tid >> 4, n = (tid & 15) * 4; *(float4*)&Bs[kk][n] = *(const float4*)(w1 + (size_t)(k0 + kk) * N + n0 + n);
      if (MODE == 1) *(float4*)&Bs3[kk][n] = *(const float4*)(w3 + (size_t)(k0 + kk) * N + n0 + n); }
    __syncthreads();
#pragma unroll
    for (int kk = 0; kk < 16; ++kk) {
      float4 a = *(const float4*)&As[kk][ty * 4]; float4 bv = *(const float4*)&Bs[kk][tx * 4];
      float av4[4] = {a.x, a.y, a.z, a.w}, bw[4] = {bv.x, bv.y, bv.z, bv.w};
#pragma unroll
      for (int i = 0; i < 4; ++i)
#pragma unroll
        for (int j = 0; j < 4; ++j) acc[i][j] += av4[i] * bw[j];
      if (MODE == 1) {
        float4 b3 = *(const float4*)&Bs3[kk][tx * 4]; float bw3[4] = {b3.x, b3.y, b3.z, b3.w};
#pragma unroll
        for (int i = 0; i < 4; ++i)
#pragma unroll
          for (int j = 0; j < 4; ++j) acc3[i][j] += av4[i] * bw3[j];
      }
    }
    __syncthreads();
  }
#pragma unroll
  for (int i = 0; i < 4; ++i) {
    int r = m0 + ty * 4 + i; if (r >= ce) continue;
#pragma unroll
    for (int j = 0; j < 4; ++j) {
      int n = n0 + tx * 4 + j;
      float v = MODE == 1 ? siluf_(acc[i][j]) * acc3[i][j] : acc[i][j];
      C[(size_t)(be + r) * N + n] = v;
    }
  }
}
__global__ __launch_bounds__(256) void k_moe_combine(float* H, const float* yb, const int* base, const int* tok_e, const int* tok_slot, const float* tok_w, const float* modl) {
  int t = blockIdx.x, b = t / S_;
  int r0 = base[tok_e[t * 2]] + tok_slot[t * 2], r1 = base[tok_e[t * 2 + 1]] + tok_slot[t * 2 + 1];
  float w0 = tok_w[t * 2], w1 = tok_w[t * 2 + 1];
  for (int n = threadIdx.x; n < D_; n += 256)
    H[(size_t)t * D_ + n] += modl[b * 6144 + 5 * 1024 + n] * (w0 * yb[(size_t)r0 * D_ + n] + w1 * yb[(size_t)r1 * D_ + n]);
}

extern "C" void kernel_launch(void* const* d_in, const int* in_sizes, int n_in, void* d_out, int out_size, void* d_ws, size_t ws_size, hipStream_t stream) {
  const float* x = (const float*)d_in[0]; const float* c = (const float*)d_in[1];
  const float* norm1 = (const float*)d_in[2]; const float* norm2 = (const float*)d_in[3];
  const float* w_ada = (const float*)d_in[4]; const float* b_ada = (const float*)d_in[5];
  const float* w_in_ab = (const float*)d_in[6]; const float* conv_a_w = (const float*)d_in[7]; const float* conv_a_b = (const float*)d_in[8];
  const float* rg_wa = (const float*)d_in[9]; const float* rg_ba = (const float*)d_in[10]; const float* rg_wx = (const float*)d_in[11]; const float* rg_bx = (const float*)d_in[12];
  const float* rg_lam = (const float*)d_in[13]; const float* gla_wg2 = (const float*)d_in[14]; const float* gla_bg2 = (const float*)d_in[15]; const float* gla_norm = (const float*)d_in[16];
  const float* w_out_ab = (const float*)d_in[17]; const float* w_in_c = (const float*)d_in[18]; const float* conv_c_w = (const float*)d_in[19];
  const float* dn_a_log = (const float*)d_in[20]; const float* dn_dt_bias = (const float*)d_in[21]; const float* dn_norm = (const float*)d_in[22]; const float* w_out_c = (const float*)d_in[23];
  const float* moe_w_grp = (const float*)d_in[24]; const float* moe_b_grp = (const float*)d_in[25]; const float* moe_w_rt = (const float*)d_in[26]; const float* moe_b_rt = (const float*)d_in[27];
  const float* moe_w1 = (const float*)d_in[28]; const float* moe_w3 = (const float*)d_in[29]; const float* moe_w2 = (const float*)d_in[30]; const float* final_norm = (const float*)d_in[31];
  float* out = (float*)d_out;
  float* H = out;
  float* ws = (float*)d_ws; size_t o = 0;
  auto take = [&](size_t n) { float* p = ws + o; o += (n + 63) & ~(size_t)63; return p; };
  float* MOD = take(4 * 6144);
  int* CNT = (int*)take(64); int* BASE = (int*)take(64);
  int* LIST = (int*)take((size_t)32 * T_); int* TOK_E = (int*)take(2 * T_); int* TOK_S = (int*)take(2 * T_); float* TOK_W = take(2 * T_);
  float* XN = take((size_t)T_ * D_);
  float* Y = take((size_t)T_ * D_);
  float* PB = take((size_t)T_ * PC);
  float* R0 = take((size_t)T_ * D_);
  float* BETA = take((size_t)T_ * 8); float* G = take((size_t)T_ * 8);
  float* HMID = PB;
  float* YB = PB + (size_t)2 * T_ * 512;
  if (o * 4 > ws_size) { fprintf(stderr, "workspace too small: need %zu have %zu\n", o * 4, ws_size); return; }

  k_mod<<<48, 256, 0, stream>>>(c, w_ada, b_ada, MOD, CNT);
  for (int l = 0; l < 2; ++l) {
    const float* modl = MOD + l * 2 * 6144;
    const float* hin = l == 0 ? x : H;
    k_norm_mod<<<T_ / 4, 256, 0, stream>>>(hin, norm1 + l * D_, modl, 0, 1, XN);
    if (l == 0) {
      k_gemm<0><<<dim3((PAB + 63) / 64, T_ / 64), 256, 0, stream>>>(XN, D_, w_in_ab, PAB, PB, PAB, T_, PAB, D_, nullptr, nullptr);
      k_rg_gates<<<T_, 512, 0, stream>>>(PB, conv_a_w, conv_a_b, rg_wa, rg_ba, rg_wx, rg_bx, rg_lam, R0, XN);
      k_rg_scan<<<16, 64, 0, stream>>>(R0, XN, PB, Y);
      k_gla_lg<<<T_, 256, 0, stream>>>(PB, gla_wg2, gla_bg2, R0);
      k_gla_rec<<<8, 128, 0, stream>>>(PB, R0, XN);
      k_head_norm_gate<<<T_ * 4 / 4, 256, 0, stream>>>(XN, 512, gla_norm, PB, PAB, 2048, Y, 512, 4);
      k_gemm<1><<<dim3(D_ / 64, T_ / 64), 256, 0, stream>>>(Y, D_, w_out_ab, D_, H, D_, T_, D_, D_, x, modl + 2 * 1024);
    } else {
      k_gemm<0><<<dim3((PC + 63) / 64, T_ / 64), 256, 0, stream>>>(XN, D_, w_in_c, PC, PB, PC, T_, PC, D_, nullptr, nullptr);
      k_dn_prep<<<T_, 256, 0, stream>>>(PB, conv_c_w, dn_a_log, dn_dt_bias, XN, R0, Y, BETA, G);
      k_dn_rec<<<16, 128, 0, stream>>>(XN, R0, Y, BETA, G, Y);
      k_head_norm_gate<<<T_ * 8 / 4, 256, 0, stream>>>(Y, D_, dn_norm, PB, PC, 3072, XN, 0, 8);
      k_gemm<1><<<dim3(D_ / 64, T_ / 64), 256, 0, stream>>>(XN, D_, w_out_c, D_, H, D_, T_, D_, D_, H, modl + 2 * 1024);
    }
    k_norm_mod<<<T_ / 4, 256, 0, stream>>>(H, norm2 + l * D_, modl, 3, 4, XN);
    if (l == 1) hipMemsetAsync(CNT, 0, 64 * 4, stream);
    k_router<<<T_, 64, 0, stream>>>(XN, moe_w_grp + l * D_ * 4, moe_b_grp + l * 4, moe_w_rt + l * D_ * 32, moe_b_rt + l * 32, CNT, LIST, TOK_E, TOK_S, TOK_W);
    k_moe_base<<<1, 64, 0, stream>>>(CNT, BASE);
    k_moe_gemm<1><<<dim3(512 / 64, T_ / 64, 32), 256, 0, stream>>>(XN, moe_w1 + (size_t)l * 32 * 1024 * 512, moe_w3 + (size_t)l * 32 * 1024 * 512, HMID, CNT, BASE, LIST);
    k_moe_gemm<2><<<dim3(1024 / 64, T_ / 64, 32), 256, 0, stream>>>(HMID, moe_w2 + (size_t)l * 32 * 512 * 1024, nullptr, YB, CNT, BASE, LIST);
    k_moe_combine<<<T_, 256, 0, stream>>>(H, YB, BASE, TOK_E, TOK_S, TOK_W, modl);
  }
  k_norm_mod<<<T_ / 4, 256, 0, stream>>>(H, final_norm, MOD, 0, -1, out);
}
```

```cpp
#include <hip/hip_runtime.h>
#include <hip/hip_cooperative_groups.h>
#include <cstdio>
#include <cstdint>
namespace cg = cooperative_groups;

#define LAS __attribute__((address_space(3)))
typedef unsigned short bf16_t;
typedef short bf16x8 __attribute__((ext_vector_type(8)));
typedef float f32x4 __attribute__((ext_vector_type(4)));
typedef unsigned u32x4 __attribute__((ext_vector_type(4)));
typedef unsigned u32x2 __attribute__((ext_vector_type(2)));

constexpr int T_ = 16384, D_ = 1024, S_ = 8192;
constexpr int PAB = 2576, PC = 4112;
constexpr int LDP0 = 2560, LDP1 = 4096;
constexpr float EPS = 1e-6f;
constexpr int NTHR = 512, NWAVE = 8;
constexpr int LDS_BYTES = 151552;
constexpr int MAXROWS = 40960;

__device__ __forceinline__ float sigmoidf_(float x) { return 1.f / (1.f + __expf(-x)); }
__device__ __forceinline__ float siluf_(float x) { return x / (1.f + __expf(-x)); }
__device__ __forceinline__ float softplusf_(float x) { return x > 20.f ? x : log1pf(__expf(x)); }
__device__ __forceinline__ float gelu_tanh(float x) { return 0.5f * x * (1.f + tanhf(0.7978845608028654f * (x + 0.044715f * x * x * x))); }
__device__ __forceinline__ float wave_sum(float v) {
#pragma unroll
  for (int o = 32; o > 0; o >>= 1) v += __shfl_xor(v, o);
  return v;
}
__device__ __forceinline__ unsigned f2bf(float f) { unsigned u = __float_as_uint(f); return (u + 0x7fffu + ((u >> 16) & 1u)) >> 16; }
__device__ __forceinline__ float bf2f(unsigned h) { return __uint_as_float(h << 16); }
__device__ __forceinline__ unsigned pk2(float lo, float hi) { return f2bf(lo) | (f2bf(hi) << 16); }

namespace pg8 {
constexpr int BM = 256, BK = 64, HALF = 128, HTB = HALF * BK * 2, STAGE_BYTES = 8 * HTB, NXCD = 8, WGM = 8;
__device__ __forceinline__ int lds_byte(int r, int c) { const int st = (r >> 4) * 2 + (c >> 5), rr = r & 15, cc = c & 31, ob = rr * 64 + cc * 2; return st * 1024 + (ob ^ (((ob >> 9) & 1) << 5)); }
__device__ __forceinline__ void stage_rc(int b, int& R, int& C) { const int st = b / 1024, sb = b % 1024, swz = sb ^ (((sb >> 9) & 1) << 5); R = (st >> 1) * 16 + swz / 64; C = (st & 1) * 32 + (swz % 64) / 2; }
__device__ __forceinline__ int perm32(int rho) { const int n = rho >> 4, i = rho & 15; return 8 * (i >> 2) + 4 * n + (i & 3); }

struct Unit { int pm, pn, pc, e, slot0, cnt; };

struct StaticOrder {
  static constexpr bool GATHER = false;
  int nM, nN, nwg, G, c, K;
  __device__ void init(int M, int N, int K_, int G_, int c_) { nM = M / BM; nN = N / BM; nwg = nM * nN; G = G_; c = c_; K = K_; }
  __device__ bool next(int i, Unit& u) const {
    const long L = (long)i * G + c; if (L >= nwg) return false;
    int wgid = (int)L; { const int q = nwg / NXCD, r = nwg % NXCD, xcd = wgid % NXCD, off = wgid / NXCD; wgid = (xcd < r ? xcd * (q + 1) : r * (q + 1) + (xcd - r) * q) + off; }
    const int nig = WGM * nN, gid = wgid / nig, fm = gid * WGM, gsz = (nM - fm) < WGM ? (nM - fm) : WGM;
    u.pm = fm + ((wgid % nig) % gsz); u.pn = (wgid % nig) / gsz; u.pc = u.pn; u.e = 0; u.slot0 = 0; u.cnt = 0; return true;
  }
  __device__ __forceinline__ unsigned aoff(const Unit& u, int row, int col) const { return (unsigned)(((u.pm * BM + row) * K + col) * 2); }
};

__device__ __forceinline__ unsigned cvt_pk_bf16(float lo, float hi) { unsigned r; asm volatile("v_cvt_pk_bf16_f32 %0, %1, %2" : "=v"(r) : "v"(lo), "v"(hi)); return r; }

struct EpiBf16 {
  static constexpr bool PERM = true;
  bf16_t* O; int ldc;
  __device__ __forceinline__ void operator()(const f32x4 (&acc)[2][2][4][2], const Unit& u, int wr, int wc, int fr, int fq) const {
    const int row0 = u.pm * BM + wr * 64 + fr, col0 = u.pc * BM + wc * 32 + 8 * fq;
#pragma unroll
    for (int ai = 0; ai < 2; ++ai)
#pragma unroll
      for (int m = 0; m < 4; ++m) { bf16_t* rowp = O + (size_t)(row0 + ai * HALF + m * 16) * ldc + col0;
#pragma unroll
        for (int bj = 0; bj < 2; ++bj) { const f32x4 v0 = acc[ai][bj][m][0], v1 = acc[ai][bj][m][1];
          u32x4 w; w.x = cvt_pk_bf16(v0[0], v0[1]); w.y = cvt_pk_bf16(v0[2], v0[3]); w.z = cvt_pk_bf16(v1[0], v1[1]); w.w = cvt_pk_bf16(v1[2], v1[3]);
          *(u32x4*)(rowp + bj * HALF) = w; } }
  }
};
struct EpiResGate {
  static constexpr bool PERM = false;
  const float* res; float* out; const float* gate;
  __device__ __forceinline__ void operator()(const f32x4 (&acc)[2][2][4][2], const Unit& u, int wr, int wc, int fr, int fq) const {
#pragma unroll
    for (int ai = 0; ai < 2; ++ai)
#pragma unroll
      for (int m = 0; m < 4; ++m) { const int row = u.pm * BM + ai * HALF + wr * 64 + m * 16 + fr; const int b = row / S_;
#pragma unroll
        for (int bj = 0; bj < 2; ++bj)
#pragma unroll
          for (int n = 0; n < 2; ++n) { const int col = u.pc * BM + bj * HALF + wc * 32 + n * 16 + 4 * fq;
            const f32x4 g = *(const f32x4*)(gate + b * 6144 + col); const f32x4 r = *(const f32x4*)(res + (size_t)row * D_ + col);
            *(f32x4*)(out + (size_t)row * D_ + col) = r + g * acc[ai][bj][m][n]; } }
  }
};
struct EpiSwiglu {
  static constexpr bool PERM = true;
  bf16_t* O;
  __device__ __forceinline__ void operator()(const f32x4 (&acc)[2][2][4][2], const Unit& u, int wr, int wc, int fr, int fq) const {
    const int row0 = u.pm * BM + wr * 64 + fr, col0 = u.pc * HALF + wc * 32 + 8 * fq;
#pragma unroll
    for (int ai = 0; ai < 2; ++ai)
#pragma unroll
      for (int m = 0; m < 4; ++m) { bf16_t* rowp = O + (size_t)(row0 + ai * HALF + m * 16) * 512 + col0;
        float v[8];
#pragma unroll
        for (int n = 0; n < 2; ++n)
#pragma unroll
          for (int i = 0; i < 4; ++i) { const float g = acc[ai][0][m][n][i], up = acc[ai][1][m][n][i]; v[n * 4 + i] = g / (1.f + __expf(-g)) * up; }
        u32x4 w; w.x = cvt_pk_bf16(v[0], v[1]); w.y = cvt_pk_bf16(v[2], v[3]); w.z = cvt_pk_bf16(v[4], v[5]); w.w = cvt_pk_bf16(v[6], v[7]);
        *(u32x4*)rowp = w; }
  }
};

template <class Epi, class Sched, bool ALIGN_EPI>
__device__ __forceinline__ void gemm_phase(LAS unsigned char* lds, const bf16_t* A, const bf16_t* Bt, int K, const Sched& S, const Epi& E) {
  const int tid = threadIdx.x, wid = __builtin_amdgcn_readfirstlane(tid >> 6), lane = tid & 63, wr = wid >> 2, wc = wid & 3, fr = lane & 15, fq = lane >> 4;
  const int nt = K / BK;
  int Rr[2], Cc[2]; unsigned voffB[2];
#pragma unroll
  for (int i = 0; i < 2; ++i) { int R, C; stage_rc(tid * 16 + i * 8192, R, C); Rr[i] = R; Cc[i] = C; const int Rb = Epi::PERM ? ((R & ~31) + perm32(R & 31)) : R; voffB[i] = (unsigned)(Rb * K + C) * 2u; }
  const size_t kstep = (size_t)(BK * 2), hstep = (size_t)HALF * K * 2, tstep = 2 * hstep;
  const unsigned ldsw = (unsigned)wid * 1024u;
  const int aoff = lds_byte(wr * 64 + fr, fq * 8), boff = lds_byte(wc * 32 + fr, fq * 8);
#define PG8_SA(b, h) (((b) * 2 + (h)) * HTB)
#define PG8_SB(b, h) ((4 + (b) * 2 + (h)) * HTB)
#define PG8_STAGE(bufoff, gbase, voff) do { _Pragma("unroll") for (int _i = 0; _i < 2; ++_i) \
    __builtin_amdgcn_global_load_lds((const unsigned*)((const char*)(gbase) + (voff)[_i]), (LAS unsigned*)(lds + (bufoff) + ldsw + _i * 8192), 16, 0, 0); } while (0)
#define PG8_LDA(dst, b, h) do { _Pragma("unroll") for (int m = 0; m < 4; ++m) _Pragma("unroll") for (int k = 0; k < 2; ++k) dst[m][k] = *(const LAS bf16x8*)(lds + PG8_SA(b, h) + aoff + m * 2048 + k * 1024); } while (0)
#define PG8_LDB(dst, b, h) do { _Pragma("unroll") for (int n = 0; n < 2; ++n) _Pragma("unroll") for (int k = 0; k < 2; ++k) dst[n][k] = *(const LAS bf16x8*)(lds + PG8_SB(b, h) + boff + n * 2048 + k * 1024); } while (0)
#define PG8_MMA(ai, bj, At, Bt_) do { __builtin_amdgcn_s_setprio(1); _Pragma("unroll") for (int m = 0; m < 4; ++m) _Pragma("unroll") for (int n = 0; n < 2; ++n) _Pragma("unroll") for (int k = 0; k < 2; ++k) \
    acc[ai][bj][m][n] = __builtin_amdgcn_mfma_f32_16x16x32_bf16(Bt_[n][k], At[m][k], acc[ai][bj][m][n], 0, 0, 0); __builtin_amdgcn_s_setprio(0); } while (0)
#define PG8_WAIT_V(n) asm volatile("s_waitcnt vmcnt(" #n ")" ::: "memory")
#define PG8_WAIT_L(n) asm volatile("s_waitcnt lgkmcnt(" #n ")" ::: "memory")
#define PG8_BAR __builtin_amdgcn_s_barrier()
#define PG8_SCHED __builtin_amdgcn_sched_barrier(0)
  Unit cur, nxt; int ui = 0;
  if (!S.next(0, cur)) return;
  f32x4 acc[2][2][4][2];
#pragma unroll
  for (int a = 0; a < 2; ++a)
#pragma unroll
    for (int b = 0; b < 2; ++b)
#pragma unroll
      for (int m = 0; m < 4; ++m)
#pragma unroll
        for (int n = 0; n < 2; ++n) acc[a][b][m][n] = (f32x4){0.f, 0.f, 0.f, 0.f};
  bf16x8 At[4][2], B0[2][2], B1[2][2];
  constexpr bool GATHER = Sched::GATHER;
  unsigned cA0[2], cA1[2], nA0[2], nA1[2];
  const char* Ab = (const char*)A;
  const char* nAb = Ab;
  if constexpr (GATHER) {
#pragma unroll
    for (int i = 0; i < 2; ++i) { cA0[i] = S.aoff(cur, Rr[i], Cc[i]); cA1[i] = S.aoff(cur, HALF + Rr[i], Cc[i]); }
  } else {
#pragma unroll
    for (int i = 0; i < 2; ++i) { cA0[i] = (unsigned)(Rr[i] * K + Cc[i]) * 2u; cA1[i] = cA0[i] + (unsigned)hstep; }
    Ab = (const char*)A + (size_t)cur.pm * tstep;
  }
  const char* cB = (const char*)Bt + (size_t)cur.pn * tstep;
  PG8_STAGE(PG8_SB(0, 0), cB, voffB); PG8_STAGE(PG8_SB(0, 1), cB + hstep, voffB); PG8_STAGE(PG8_SA(0, 0), Ab, cA0); PG8_STAGE(PG8_SA(0, 1), Ab, cA1);
  if (wr == 1) PG8_BAR;
  PG8_WAIT_V(2); PG8_BAR;
  PG8_STAGE(PG8_SB(1, 0), cB + kstep, voffB); PG8_STAGE(PG8_SA(1, 0), Ab + kstep, cA0); PG8_STAGE(PG8_SB(1, 1), cB + hstep + kstep, voffB);
  PG8_WAIT_V(6); PG8_BAR;
  for (;;) {
    const bool has_next = S.next(ui + 1, nxt);
    if constexpr (GATHER) {
#pragma unroll
      for (int i = 0; i < 2; ++i) { nA0[i] = has_next ? S.aoff(nxt, Rr[i], Cc[i]) : cA0[i]; nA1[i] = has_next ? S.aoff(nxt, HALF + Rr[i], Cc[i]) : cA1[i]; }
    } else { nAb = has_next ? (const char*)A + (size_t)nxt.pm * tstep : Ab; }
    const char* nB = has_next ? (const char*)Bt + (size_t)nxt.pn * tstep : cB;
    for (int t = 0; t < nt; t += 2) {
      const bool last = (t == nt - 2);
      const char* a1 = Ab + (size_t)(t + 1) * kstep;
      const char* a2 = last ? nAb : Ab + (size_t)(t + 2) * kstep; const char* b2 = last ? nB : cB + (size_t)(t + 2) * kstep;
      const char* a3 = a2 + kstep; const char* b3 = b2 + kstep;
      PG8_LDB(B0, 0, 0); PG8_LDB(B1, 0, 1); PG8_SCHED; PG8_LDA(At, 0, 0); PG8_STAGE(PG8_SA(1, 1), a1, cA1);
      if constexpr (GATHER) { if (last) {
#pragma unroll
        for (int i = 0; i < 2; ++i) { cA0[i] = nA0[i]; cA1[i] = nA1[i]; } } }
      PG8_WAIT_V(8); PG8_WAIT_L(0); PG8_BAR; PG8_MMA(0, 0, At, B0); PG8_MMA(0, 1, At, B1); PG8_BAR; PG8_SCHED;
      PG8_LDA(At, 0, 1); PG8_STAGE(PG8_SB(0, 0), b2, voffB); PG8_STAGE(PG8_SB(0, 1), b2 + hstep, voffB); PG8_STAGE(PG8_SA(0, 0), a2, cA0);
      PG8_WAIT_V(8); PG8_WAIT_L(0); PG8_BAR; PG8_MMA(1, 0, At, B0); PG8_MMA(1, 1, At, B1); PG8_BAR; PG8_SCHED;
      PG8_LDB(B0, 1, 0); PG8_LDB(B1, 1, 1); PG8_SCHED; PG8_LDA(At, 1, 0); PG8_STAGE(PG8_SA(0, 1), a2, cA1);
      PG8_WAIT_V(8); PG8_WAIT_L(0); PG8_BAR; PG8_MMA(0, 0, At, B0); PG8_MMA(0, 1, At, B1); PG8_BAR; PG8_SCHED;
      PG8_LDA(At, 1, 1); PG8_STAGE(PG8_SB(1, 0), b3, voffB); PG8_STAGE(PG8_SB(1, 1), b3 + hstep, voffB); PG8_STAGE(PG8_SA(1, 0), a3, cA0);
      PG8_WAIT_V(8); PG8_WAIT_L(0); PG8_BAR; PG8_MMA(1, 0, At, B0); PG8_MMA(1, 1, At, B1); PG8_BAR; PG8_SCHED;
    }
    if constexpr (ALIGN_EPI) { if (wr == 0) PG8_BAR; }
    E(acc, cur, wr, wc, fr, fq);
    if (!has_next) break;
#pragma unroll
    for (int a = 0; a < 2; ++a)
#pragma unroll
      for (int b = 0; b < 2; ++b)
#pragma unroll
        for (int m = 0; m < 4; ++m)
#pragma unroll
          for (int n = 0; n < 2; ++n) acc[a][b][m][n] = (f32x4){0.f, 0.f, 0.f, 0.f};
    cur = nxt; cB = nB; ++ui;
    if constexpr (!GATHER) Ab = nAb;
    if constexpr (ALIGN_EPI) { if (wr == 1) PG8_BAR; }
  }
  PG8_WAIT_V(0);
  if constexpr (!ALIGN_EPI) { if (wr == 0) PG8_BAR; }
  PG8_BAR;
#undef PG8_SA
#undef PG8_SB
#undef PG8_STAGE
#undef PG8_LDA
#undef PG8_LDB
#undef PG8_MMA
#undef PG8_WAIT_V
#undef PG8_WAIT_L
#undef PG8_BAR
#undef PG8_SCHED
}
}

struct Args {
  const float* in[32];
  float* out;
  unsigned char* ws;
  int ph_lo, ph_hi;
};
constexpr size_t MiB = 1u << 20;
constexpr size_t WS_CTL = 0;
constexpr size_t WS_MOD = 64 * 1024;
constexpr size_t WS_TOK = 1 * MiB;
constexpr size_t WS_LIST = 2 * MiB;
constexpr size_t WS_SK = 4 * MiB;
constexpr size_t WS_WIN0 = 6 * MiB;
constexpr size_t WS_WOUT0 = 11 * MiB;
constexpr size_t WS_WIN1 = 13 * MiB;
constexpr size_t WS_WOUT1 = 21 * MiB;
constexpr size_t WS_W13 = 24 * MiB;
constexpr size_t WS_W2 = 88 * MiB;
constexpr size_t WS_XN = 120 * MiB;
constexpr size_t WS_Y = 152 * MiB;
constexpr size_t WS_P = 184 * MiB;
constexpr size_t WS_HMID = WS_P;
constexpr size_t WS_YB = WS_P + 40 * MiB;
constexpr size_t WS_SCR = 312 * MiB;
constexpr size_t WS_END = 504 * MiB;

struct Frame {
  LAS unsigned char* lds;
  int tid, lane, wave, G, bid;
  float* out; unsigned char* ws;
};

__device__ __forceinline__ void transpose_item(const float* W, int ldw, int K, bf16_t* WT, int k0, int n0, int row0, LAS float* scr, int lane) {
#pragma unroll 8
  for (int i = 0; i < 32; ++i) { const int kk = 2 * i + (lane >> 5); scr[kk * 33 + (lane & 31)] = W[(size_t)(k0 + kk) * ldw + n0 + (lane & 31)]; }
  asm volatile("s_waitcnt lgkmcnt(0)" ::: "memory");
  const int c = lane & 7;
#pragma unroll
  for (int j = 0; j < 4; ++j) { const int n = (lane >> 3) + 8 * j; const LAS float* s = scr + (8 * c) * 33 + n;
    u32x4 o; o.x = pk2(s[0 * 33], s[1 * 33]); o.y = pk2(s[2 * 33], s[3 * 33]); o.z = pk2(s[4 * 33], s[5 * 33]); o.w = pk2(s[6 * 33], s[7 * 33]);
    *(u32x4*)(WT + (size_t)(row0 + n) * K + k0 + 8 * c) = o; }
  asm volatile("s_waitcnt lgkmcnt(0)" ::: "memory");
}
__device__ __forceinline__ void convert_moe(Frame& F, const Args& A, int layer) {
  LAS float* scr = (LAS float*)(F.lds + F.wave * 16384);
  const int gw = F.bid * NWAVE + F.wave, NGW = F.G * NWAVE;
  for (int it = gw; it < 32 * 768; it += NGW) {
    const int e = it / 768; int r = it % 768; const int le = layer * 32 + e;
    if (r < 512) {
      const int which = r >> 8, rr = r & 255, kb = rr / 16, nb = rr % 16, n0 = nb * 32;
      const float* W = (which ? A.in[29] : A.in[28]) + (size_t)le * 1024 * 512;
      transpose_item(W, 512, 1024, (bf16_t*)(F.ws + WS_W13) + (size_t)e * 1024 * 1024, kb * 64, n0, (n0 >> 7) * 256 + (n0 & 127) + which * 128, scr, F.lane);
    } else {
      const int rr = r - 512, kb = rr / 32, nb = rr % 32;
      transpose_item(A.in[30] + (size_t)le * 512 * 1024, 1024, 512, (bf16_t*)(F.ws + WS_W2) + (size_t)e * 1024 * 512, kb * 64, nb * 32, nb * 32, scr, F.lane);
    }
  }
}
__device__ __forceinline__ void ph_prologue(Frame& F, const Args& A) {
  LAS float* scr = (LAS float*)(F.lds + F.wave * 16384);
  const int gw = F.bid * NWAVE + F.wave, NGW = F.G * NWAVE;
  if (F.bid == 0 && F.tid < 64) ((int*)(F.ws + WS_CTL))[F.tid] = 0;
  constexpr int I_IN0 = 16 * 80, I_OUT = 16 * 32, I_IN1 = 16 * 128;
  constexpr int NIT = I_IN0 + I_OUT + I_IN1 + I_OUT;
  for (int it = gw; it < NIT; it += NGW) {
    int r = it;
    if (r < I_IN0) { const int kb = r / 80, nb = r % 80; transpose_item(A.in[6], PAB, 1024, (bf16_t*)(F.ws + WS_WIN0), kb * 64, nb * 32, nb * 32, scr, F.lane); continue; } r -= I_IN0;
    if (r < I_OUT) { const int kb = r / 32, nb = r % 32; transpose_item(A.in[17], 1024, 1024, (bf16_t*)(F.ws + WS_WOUT0), kb * 64, nb * 32, nb * 32, scr, F.lane); continue; } r -= I_OUT;
    if (r < I_IN1) { const int kb = r / 128, nb = r % 128; transpose_item(A.in[18], PC, 1024, (bf16_t*)(F.ws + WS_WIN1), kb * 64, nb * 32, nb * 32, scr, F.lane); continue; } r -= I_IN1;
    { const int kb = r / 32, nb = r % 32; transpose_item(A.in[23], 1024, 1024, (bf16_t*)(F.ws + WS_WOUT1), kb * 64, nb * 32, nb * 32, scr, F.lane); }
  }
  const float* c = A.in[1]; const float* w_ada = A.in[4]; const float* b_ada = A.in[5]; float* mod = (float*)(F.ws + WS_MOD);
  for (int un = gw; un < 384; un += NGW) {
    const int l = un / 192, n0 = (un % 192) * 32, kg = F.lane >> 3, cq = F.lane & 7;
    f32x4 a0 = {0.f, 0.f, 0.f, 0.f}, a1 = {0.f, 0.f, 0.f, 0.f};
    const float* w = w_ada + (size_t)l * 1024 * 6144 + n0 + cq * 4;
#pragma unroll 4
    for (int k = kg * 128; k < kg * 128 + 128; ++k) { const f32x4 wv = *(const f32x4*)(w + (size_t)k * 6144); const float c0 = siluf_(c[k]), c1 = siluf_(c[1024 + k]); a0 += wv * c0; a1 += wv * c1; }
#pragma unroll
    for (int o = 8; o < 64; o <<= 1)
#pragma unroll
      for (int i = 0; i < 4; ++i) { a0[i] += __shfl_xor(a0[i], o); a1[i] += __shfl_xor(a1[i], o); }
    if (kg == 0) { const f32x4 bb = *(const f32x4*)(b_ada + l * 6144 + n0 + cq * 4);
      *(f32x4*)(mod + (l * 2 + 0) * 6144 + n0 + cq * 4) = a0 + bb; *(f32x4*)(mod + (l * 2 + 1) * 6144 + n0 + cq * 4) = a1 + bb; }
  }
}

template <int MODE>
__device__ __forceinline__ void ph_norm(Frame& F, const Args& A, int l) {
  constexpr bool COMBINE = (MODE == 1 || MODE == 3);
  constexpr int NS = (MODE == 2) ? 36 : (MODE == 3 ? 0 : 16);
  constexpr int NSP = (MODE == 2) ? 36 : 20;
  LAS float* wl = (LAS float*)F.lds;
  LAS int* tb = (LAS int*)(F.lds + 147456);
  const float* mod = (const float*)(F.ws + WS_MOD);
  if (NS > 0) {
    for (int idx = F.tid; idx < 1024 * NS; idx += NTHR) {
      const int k = idx / NS, n = idx % NS; float v;
      if (MODE == 2) v = n < 4 ? A.in[24][(size_t)l * 4096 + k * 4 + n] : A.in[26][(size_t)l * 32768 + k * 32 + (n - 4)];
      else v = MODE == 0 ? A.in[6][(size_t)k * PAB + 2560 + n] : A.in[18][(size_t)k * PC + 4096 + n];
      const int rho = ((k >> 2) & 63) + 64 * (((k >> 8) << 2) + (k & 3));
      wl[rho * NSP + n] = v;
    }
  }
  const int lc = (MODE == 1) ? 0 : 1;
  if (COMBINE) { if (F.tid == 0) { const int* cnt = (const int*)(F.ws + WS_CTL) + lc * 32; int acc = 0;
#pragma unroll 1
    for (int e = 0; e < 32; ++e) { tb[e] = acc; acc += (cnt[e] + 255) >> 8; } } }
  __syncthreads();
  const float* hin = (MODE == 0) ? A.in[0] : F.out;
  const float* gvec = (MODE == 3) ? A.in[31] : (MODE == 2 ? A.in[3] + l * D_ : A.in[2] + l * D_);
  const float* modl = mod + l * 2 * 6144;
  const int shp = (MODE == 2) ? 3 : 0, scp = (MODE == 2) ? 4 : 1;
  const int* tok_e = (const int*)(F.ws + WS_TOK); const int* tok_s = tok_e + 2 * T_; const float* tok_w = (const float*)(tok_s + 2 * T_);
  const bf16_t* yb = (const bf16_t*)(F.ws + WS_YB);
  bf16_t* xn = (bf16_t*)(F.ws + WS_XN);
  const int gw = F.bid * NWAVE + F.wave, NGW = F.G * NWAVE, lane = F.lane;
  constexpr int RPW = 2;
  for (int it = gw; it < T_ / RPW; it += NGW) {
    float u[RPW][16];
#pragma unroll
    for (int r = 0; r < RPW; ++r) {
      const int row = it * RPW + r, b = row / S_;
      const float* hr = hin + (size_t)row * D_;
      float v[16];
#pragma unroll
      for (int j = 0; j < 4; ++j) { const f32x4 x = *(const f32x4*)(hr + lane * 4 + 256 * j); v[4*j] = x[0]; v[4*j+1] = x[1]; v[4*j+2] = x[2]; v[4*j+3] = x[3]; }
      if (COMBINE) {
        const int e0 = tok_e[row * 2], e1 = tok_e[row * 2 + 1];
        const int r0 = tb[e0] * 256 + tok_s[row * 2], r1 = tb[e1] * 256 + tok_s[row * 2 + 1];
        const float w0 = tok_w[row * 2], w1 = tok_w[row * 2 + 1];
        const float* g2 = mod + (lc * 2 + b) * 6144 + 5 * 1024;
#pragma unroll
        for (int j = 0; j < 4; ++j) {
          const u32x2 y0 = *(const u32x2*)(yb + (size_t)r0 * D_ + lane * 4 + 256 * j), y1 = *(const u32x2*)(yb + (size_t)r1 * D_ + lane * 4 + 256 * j);
          const f32x4 g = *(const f32x4*)(g2 + lane * 4 + 256 * j);
          v[4*j]   += g[0] * (w0 * bf2f(y0.x & 0xffffu) + w1 * bf2f(y1.x & 0xffffu));
          v[4*j+1] += g[1] * (w0 * bf2f(y0.x >> 16) + w1 * bf2f(y1.x >> 16));
          v[4*j+2] += g[2] * (w0 * bf2f(y0.y & 0xffffu) + w1 * bf2f(y1.y & 0xffffu));
          v[4*j+3] += g[3] * (w0 * bf2f(y0.y >> 16) + w1 * bf2f(y1.y >> 16));
        }
        if (MODE == 1) {
#pragma unroll
          for (int j = 0; j < 4; ++j) *(f32x4*)(F.out + (size_t)row * D_ + lane * 4 + 256 * j) = (f32x4){v[4*j], v[4*j+1], v[4*j+2], v[4*j+3]};
        }
      }
      float ss = 0.f;
#pragma unroll
      for (int i = 0; i < 16; ++i) ss += v[i] * v[i];
      ss = wave_sum(ss);
      const float rstd = rsqrtf(ss * (1.f / D_) + EPS);
#pragma unroll
      for (int j = 0; j < 4; ++j) {
        const f32x4 g = *(const f32x4*)(gvec + lane * 4 + 256 * j);
        f32x4 y = {v[4*j] * rstd * g[0], v[4*j+1] * rstd * g[1], v[4*j+2] * rstd * g[2], v[4*j+3] * rstd * g[3]};
        if (MODE != 3) { const f32x4 sc = *(const f32x4*)(modl + b * 6144 + scp * 1024 + lane * 4 + 256 * j), sh = *(const f32x4*)(modl + b * 6144 + shp * 1024 + lane * 4 + 256 * j); y = y * (1.f + sc) + sh; }
        u[r][4*j] = y[0]; u[r][4*j+1] = y[1]; u[r][4*j+2] = y[2]; u[r][4*j+3] = y[3];
        if (MODE == 3) *(f32x4*)(F.out + (size_t)row * D_ + lane * 4 + 256 * j) = y;
        else { u32x2 p; p.x = pk2(y[0], y[1]); p.y = pk2(y[2], y[3]); *(u32x2*)(xn + (size_t)row * D_ + lane * 4 + 256 * j) = p; }
      }
    }
    if (MODE == 0 || MODE == 1) {
#pragma unroll 1
      for (int cgp = 0; cgp < 4; ++cgp) {
        f32x4 a[RPW];
#pragma unroll
        for (int r = 0; r < RPW; ++r) a[r] = (f32x4){0.f, 0.f, 0.f, 0.f};
#pragma unroll
        for (int kk = 0; kk < 16; ++kk) {
          const f32x4 w = *(const LAS f32x4*)(wl + (lane + 64 * kk) * NSP + cgp * 4);
#pragma unroll
          for (int r = 0; r < RPW; ++r) a[r] += w * u[r][kk];
        }
#pragma unroll
        for (int r = 0; r < RPW; ++r)
#pragma unroll
          for (int i = 0; i < 4; ++i) a[r][i] = wave_sum(a[r][i]);
        if (lane < RPW) { const f32x4 v = lane == 0 ? a[0] : a[1]; *(f32x4*)((float*)(F.ws + WS_SK) + (size_t)(it * RPW + lane) * 16 + cgp * 4) = v; }
      }
    }
    if (MODE == 2) {
      f32x4 ag[RPW];
#pragma unroll
      for (int r = 0; r < RPW; ++r) ag[r] = (f32x4){0.f, 0.f, 0.f, 0.f};
#pragma unroll
      for (int kk = 0; kk < 16; ++kk) {
        const f32x4 w = *(const LAS f32x4*)(wl + (lane + 64 * kk) * NSP);
#pragma unroll
        for (int r = 0; r < RPW; ++r) ag[r] += w * u[r][kk];
      }
      const float* bg = A.in[25] + l * 4; const float* br = A.in[27] + l * 32;
#pragma unroll
      for (int r = 0; r < RPW; ++r) {
        const int row = it * RPW + r;
        float g4[4];
#pragma unroll
        for (int i = 0; i < 4; ++i) g4[i] = wave_sum(ag[r][i]) + bg[i];
        int gi = 0; float gm = g4[0];
#pragma unroll
        for (int i = 1; i < 4; ++i) if (g4[i] > gm) { gm = g4[i]; gi = i; }
        float se = 0.f;
#pragma unroll
        for (int i = 0; i < 4; ++i) se += __expf(g4[i] - gm);
        const float pg = 1.f / se;
        f32x4 e0v = {0.f, 0.f, 0.f, 0.f}, e1v = {0.f, 0.f, 0.f, 0.f};
#pragma unroll
        for (int kk = 0; kk < 16; ++kk) {
          const LAS float* wp = wl + (lane + 64 * kk) * NSP + 4 + gi * 8;
          e0v += *(const LAS f32x4*)wp * u[r][kk]; e1v += *(const LAS f32x4*)(wp + 4) * u[r][kk];
        }
        float le[8];
#pragma unroll
        for (int i = 0; i < 4; ++i) { le[i] = wave_sum(e0v[i]) + br[gi * 8 + i]; le[4 + i] = wave_sum(e1v[i]) + br[gi * 8 + 4 + i]; }
        float m0 = -3.4e38f, m1 = -3.4e38f; int e0 = 0, e1 = 0;
#pragma unroll
        for (int i = 0; i < 8; ++i) { const float x = le[i];
          if (x > m0) { m1 = m0; e1 = e0; m0 = x; e0 = i; } else if (x > m1) { m1 = x; e1 = i; } }
        const float p1 = __expf(m1 - m0), w0 = pg / (1.f + p1), w1 = pg * p1 / (1.f + p1);
        const int E0 = gi * 8 + e0, E1 = gi * 8 + e1;
        if (lane == 0) {
          int* cnt = (int*)(F.ws + WS_CTL) + l * 32; int* list = (int*)(F.ws + WS_LIST);
          const int s0 = atomicAdd(&cnt[E0], 1), s1 = atomicAdd(&cnt[E1], 1);
          list[E0 * T_ + s0] = row; list[E1 * T_ + s1] = row;
          int* te = (int*)(F.ws + WS_TOK); int* ts = te + 2 * T_; float* tw = (float*)(ts + 2 * T_);
          te[row * 2] = E0; te[row * 2 + 1] = E1; ts[row * 2] = s0; ts[row * 2 + 1] = s1; tw[row * 2] = w0; tw[row * 2 + 1] = w1;
        }
      }
    }
  }
}

template <bool GATHER_> struct MoeSched {
  static constexpr bool GATHER = GATHER_;
  const LAS int* tb; const LAS int* cn; const int* list; int G, c, K, ntot;
  __device__ bool next(int i, pg8::Unit& u) const {
    const int L = i * G + c; if (L >= ntot * 4) return false;
    const int rt = L >> 2, pc = L & 3; const int e = tb[80 + rt];
    u.pm = rt; u.pc = pc; u.pn = e * 4 + pc; u.e = e; u.slot0 = (rt - tb[e]) * 256; u.cnt = cn[e]; return true;
  }
  __device__ __forceinline__ unsigned aoff(const pg8::Unit& u, int row, int col) const {
    if (GATHER) { const int s = u.slot0 + row; const int tok = s < u.cnt ? list[u.e * T_ + s] : 0; return (unsigned)((tok * K + col) * 2); }
    return (unsigned)(((u.pm * 256 + row) * K + col) * 2);
  }
};
__device__ __forceinline__ void moe_tables(Frame& F, int l, LAS int* tb, LAS int* cn) {
  if (F.tid == 0) { const int* cnt = (const int*)(F.ws + WS_CTL) + l * 32; int acc = 0;
#pragma unroll 1
    for (int e = 0; e < 32; ++e) { const int c = cnt[e]; tb[e] = acc; cn[e] = c; const int nt = (c + 255) >> 8;
#pragma unroll 1
      for (int j = 0; j < nt; ++j) tb[80 + acc + j] = e;
      acc += nt; }
    tb[32] = acc; }
  __syncthreads();
}

enum { PH_PRO = 0, PH_N1_0, PH_GIN_0, PH_MIX_0, PH_GOUT_0, PH_N2_0, PH_MOE1_0, PH_MOE2_0, PH_N1_1, PH_GIN_1, PH_MIX_1, PH_GOUT_1, PH_N2_1, PH_MOE1_1, PH_MOE2_1, PH_FINAL, PH_COUNT };

#define PHASE(k) if (lo <= (k) && (k) < hi && ((k) == lo || (grid.sync(), true)))
template <int L>
__device__ __forceinline__ void layer_phases(Frame& F, const Args& args, cg::grid_group& grid, int lo, int hi, LAS int* tb, LAS int* cn) {
  constexpr int B = L * (PH_N1_1 - PH_N1_0);
  PHASE(B + PH_N1_0) { if (L == 0) ph_norm<0>(F, args, 0); else { convert_moe(F, args, 1); __syncthreads(); ph_norm<1>(F, args, 1); } }
  PHASE(B + PH_GIN_0) {
    pg8::StaticOrder S; S.init(T_, L == 0 ? LDP0 : LDP1, D_, F.G, F.bid);
    pg8::EpiBf16 E{(bf16_t*)(F.ws + WS_P), L == 0 ? LDP0 : LDP1};
    pg8::gemm_phase<pg8::EpiBf16, pg8::StaticOrder, true>(F.lds, (const bf16_t*)(F.ws + WS_XN), (const bf16_t*)(F.ws + (L == 0 ? WS_WIN0 : WS_WIN1)), D_, S, E);
  }
  PHASE(B + PH_GOUT_0) {
    pg8::StaticOrder S; S.init(T_, D_, D_, F.G, F.bid);
    pg8::EpiResGate E{L == 0 ? args.in[0] : F.out, F.out, (const float*)(F.ws + WS_MOD) + L * 2 * 6144 + 2 * 1024};
    pg8::gemm_phase<pg8::EpiResGate, pg8::StaticOrder, false>(F.lds, (const bf16_t*)(F.ws + WS_Y), (const bf16_t*)(F.ws + (L == 0 ? WS_WOUT0 : WS_WOUT1)), D_, S, E);
  }
  PHASE(B + PH_N2_0) ph_norm<2>(F, args, L);
  PHASE(B + PH_MOE1_0) {
    moe_tables(F, L, tb, cn);
    MoeSched<true> S{tb, cn, (const int*)(F.ws + WS_LIST), F.G, F.bid, D_, tb[32]};
    pg8::EpiSwiglu E{(bf16_t*)(F.ws + WS_HMID)};
    pg8::gemm_phase<pg8::EpiSwiglu, MoeSched<true>, true>(F.lds, (const bf16_t*)(F.ws + WS_XN), (const bf16_t*)(F.ws + WS_W13), D_, S, E);
  }
  PHASE(B + PH_MOE2_0) {
    moe_tables(F, L, tb, cn);
    MoeSched<false> S{tb, cn, (const int*)(F.ws + WS_LIST), F.G, F.bid, 512, tb[32]};
    pg8::EpiBf16 E{(bf16_t*)(F.ws + WS_YB), D_};
    pg8::gemm_phase<pg8::EpiBf16, MoeSched<false>, true>(F.lds, (const bf16_t*)(F.ws + WS_HMID), (const bf16_t*)(F.ws + WS_W2), 512, S, E);
  }
}
#undef PHASE

__global__ void __launch_bounds__(NTHR, 2) k_fwd(Args args) {
  extern __shared__ __attribute__((aligned(16))) unsigned char lds_raw[];
  cg::grid_group grid = cg::this_grid();
  Frame F;
  F.lds = (LAS unsigned char*)lds_raw;
  F.tid = threadIdx.x; F.lane = F.tid & 63; F.wave = __builtin_amdgcn_readfirstlane(F.tid >> 6);
  F.G = gridDim.x; F.bid = blockIdx.x;
  F.out = args.out; F.ws = args.ws;
  LAS int* tb = (LAS int*)(F.lds + 132 * 1024); LAS int* cn = tb + 40;
  const int lo = args.ph_lo, hi = args.ph_hi;
#define PHASE(k) if (lo <= (k) && (k) < hi && ((k) == lo || (grid.sync(), true)))
  PHASE(PH_PRO) { ph_prologue(F, args); convert_moe(F, args, 0); }
  layer_phases<0>(F, args, grid, lo, hi, tb, cn);
  layer_phases<1>(F, args, grid, lo, hi, tb, cn);
  PHASE(PH_FINAL) ph_norm<3>(F, args, 1);
}

__device__ __forceinline__ float ldb(const bf16_t* p, size_t i) { return bf2f(p[i]); }
__global__ __launch_bounds__(512) void k_rg_gates(const bf16_t* P, const float* conv_w, const float* conv_b, const float* wa, const float* ba, const float* wx, const float* bx, const float* lam, float* Aout, float* Bout) {
  __shared__ float xc[512];
  int t = blockIdx.x, ch = threadIdx.x, tl = t % S_;
  float v = conv_b[ch];
#pragma unroll
  for (int j = 0; j < 4; ++j) { int tt = tl - 3 + j; if (tt >= 0) v += conv_w[j * 512 + ch] * ldb(P, (size_t)(t - 3 + j) * LDP0 + ch); }
  xc[ch] = v;
  __syncthreads();
  int h = ch >> 6, jj = ch & 63;
  float r = ba[ch], ii = bx[ch];
  const float* wap = wa + h * 4096 + jj; const float* wxp = wx + h * 4096 + jj;
  for (int i = 0; i < 64; ++i) { float x = xc[h * 64 + i]; r += x * wap[i * 64]; ii += x * wxp[i * 64]; }
  r = sigmoidf_(r); ii = sigmoidf_(ii);
  float log_a = -8.f * r * softplusf_(-lam[ch]);
  float a = __expf(log_a);
  float bb = sqrtf(-expm1f(2.f * log_a)) * (ii * v);
  Aout[(size_t)t * 512 + ch] = a; Bout[(size_t)t * 512 + ch] = bb;
}
__global__ __launch_bounds__(64) void k_rg_scan(const float* Ain, const float* Bin, const bf16_t* P, bf16_t* Y) {
  int idx = blockIdx.x * 64 + threadIdx.x; int b = idx >> 9, ch = idx & 511;
  float h = 0.f;
  size_t t0 = (size_t)b * S_;
#pragma unroll 8
  for (int t = 0; t < S_; ++t) {
    float a = Ain[(t0 + t) * 512 + ch], bb = Bin[(t0 + t) * 512 + ch], ga = ldb(P, (t0 + t) * LDP0 + 512 + ch);
    h = a * h + bb;
    Y[(t0 + t) * D_ + ch] = (bf16_t)f2bf(gelu_tanh(ga) * h);
  }
}
__global__ __launch_bounds__(256) void k_gla_lg(const float* SK, const float* wg2, const float* bg2, float* LG) {
  int t = blockIdx.x, n = threadIdx.x;
  float v = bg2[n];
#pragma unroll
  for (int r = 0; r < 16; ++r) v += SK[(size_t)t * 16 + r] * wg2[r * 256 + n];
  float ls = fminf(v, 0.f) - log1pf(__expf(-fabsf(v)));
  LG[(size_t)t * 256 + n] = ls * (1.f / 16.f);
}
__global__ __launch_bounds__(128) void k_gla_rec(const bf16_t* P, const float* LG, float* O) {
  int b = blockIdx.x >> 2, h = blockIdx.x & 3, j = threadIdx.x;
  float s[64];
#pragma unroll
  for (int d = 0; d < 64; ++d) s[d] = 0.f;
  for (int t = 0; t < S_; ++t) {
    size_t row = (size_t)b * S_ + t;
    const bf16_t* q = P + row * LDP0 + 1024 + h * 64;
    const bf16_t* k = P + row * LDP0 + 1280 + h * 64;
    const float* lg = LG + row * 256 + h * 64;
    float v = ldb(P, row * LDP0 + 1536 + h * 128 + j);
    float o = 0.f;
#pragma unroll
    for (int d = 0; d < 64; ++d) { s[d] = __expf(lg[d]) * s[d] + bf2f(k[d]) * v; o += bf2f(q[d]) * s[d]; }
    O[row * 512 + h * 128 + j] = o * 0.125f;
  }
}
__global__ __launch_bounds__(256) void k_head_norm_gate(const float* O, int ldo, const float* g, const bf16_t* Pgate, int ldp, int gate_off, bf16_t* Y, int y_off, int nheads) {
  int w = blockIdx.x * 4 + (threadIdx.x >> 6), lane = threadIdx.x & 63;
  int t = w / nheads, h = w % nheads;
  float o0 = O[(size_t)t * ldo + h * 128 + lane], o1 = O[(size_t)t * ldo + h * 128 + 64 + lane];
  float ss = wave_sum(o0 * o0 + o1 * o1);
  float r = rsqrtf(ss * (1.f / 128.f) + EPS);
  float g0 = ldb(Pgate, (size_t)t * ldp + gate_off + h * 128 + lane), g1 = ldb(Pgate, (size_t)t * ldp + gate_off + h * 128 + 64 + lane);
  Y[(size_t)t * D_ + y_off + h * 128 + lane] = (bf16_t)f2bf(o0 * r * g[lane] * siluf_(g0));
  Y[(size_t)t * D_ + y_off + h * 128 + 64 + lane] = (bf16_t)f2bf(o1 * r * g[64 + lane] * siluf_(g1));
}
__global__ __launch_bounds__(256) void k_dn_prep(const bf16_t* P, const float* SK, const float* conv_w, const float* a_log, const float* dt_bias, float* QN, float* KN, float* V, float* BETA, float* G) {
  __shared__ float buf[3072];
  int t = blockIdx.x, tid = threadIdx.x, tl = t % S_;
  for (int c = tid; c < 3072; c += 256) {
    float v = 0.f;
#pragma unroll
    for (int j = 0; j < 4; ++j) { int tt = tl - 3 + j; if (tt >= 0) v += conv_w[j * 3072 + c] * ldb(P, (size_t)(t - 3 + j) * LDP1 + c); }
    buf[c] = siluf_(v);
  }
  __syncthreads();
  int w = tid >> 6, lane = tid & 63;
  for (int gi = w * 4; gi < w * 4 + 4; ++gi) {
    float x0 = buf[gi * 128 + lane], x1 = buf[gi * 128 + 64 + lane];
    float ss = wave_sum(x0 * x0 + x1 * x1);
    float sc = rsqrtf(ss + EPS);
    if (gi < 8) { sc *= 0.08838834764831845f; QN[(size_t)t * D_ + gi * 128 + lane] = x0 * sc; QN[(size_t)t * D_ + gi * 128 + 64 + lane] = x1 * sc; }
    else { int c = (gi - 8) * 128; KN[(size_t)t * D_ + c + lane] = x0 * sc; KN[(size_t)t * D_ + c + 64 + lane] = x1 * sc; }
  }
  for (int c = tid; c < 1024; c += 256) V[(size_t)t * D_ + c] = buf[2048 + c];
  if (tid < 8) {
    BETA[t * 8 + tid] = sigmoidf_(SK[(size_t)t * 16 + tid]);
    G[t * 8 + tid] = -__expf(a_log[tid]) * softplusf_(SK[(size_t)t * 16 + 8 + tid] + dt_bias[tid]);
  }
}
__global__ __launch_bounds__(128) void k_dn_rec(const float* QN, const float* KN, const float* V, const float* BETA, const float* G, float* O) {
  int b = blockIdx.x >> 3, h = blockIdx.x & 7, j = threadIdx.x;
  float s[128];
#pragma unroll
  for (int d = 0; d < 128; ++d) s[d] = 0.f;
  for (int t = 0; t < S_; ++t) {
    size_t row = (size_t)b * S_ + t;
    const float* q = QN + row * D_ + h * 128;
    const float* k = KN + row * D_ + h * 128;
    float v = V[row * D_ + h * 128 + j];
    float dec = __expf(G[row * 8 + h]), beta = BETA[row * 8 + h];
    float kd = 0.f;
#pragma unroll
    for (int d = 0; d < 128; ++d) { s[d] *= dec; kd += k[d] * s[d]; }
    float vn = beta * (v - kd);
    float o = 0.f;
#pragma unroll
    for (int d = 0; d < 128; ++d) { s[d] += k[d] * vn; o += q[d] * s[d]; }
    O[row * D_ + h * 128 + j] = o;
  }
}

extern "C" void kernel_launch(void* const* d_in, const int* in_sizes, int n_in, void* d_out, int out_size, void* d_ws, size_t ws_size, hipStream_t stream) {
  static int grid = 0;
  if (grid == 0) {
    if (n_in != 32 || ws_size < WS_END) { fprintf(stderr, "kernel_launch: bad inputs / workspace (%d inputs, ws %zu < %zu)\n", n_in, ws_size, (size_t)WS_END); grid = -1; return; }
    int dev = 0, cus = 0, per_cu = 0;
    hipGetDevice(&dev); hipDeviceGetAttribute(&cus, hipDeviceAttributeMultiprocessorCount, dev);
    if (hipFuncSetAttribute((const void*)k_fwd, hipFuncAttributeMaxDynamicSharedMemorySize, LDS_BYTES) != hipSuccess) { fprintf(stderr, "hipFuncSetAttribute failed\n"); grid = -1; return; }
    if (hipOccupancyMaxActiveBlocksPerMultiprocessor(&per_cu, (const void*)k_fwd, NTHR, LDS_BYTES) != hipSuccess || per_cu < 1) { fprintf(stderr, "occupancy query failed (%d)\n", per_cu); grid = -1; return; }
    grid = cus;
  }
  if (grid < 0) return;
  Args a{};
  for (int i = 0; i < 32; ++i) a.in[i] = (const float*)d_in[i];
  a.out = (float*)d_out; a.ws = (unsigned char*)d_ws;
  auto run = [&](int lo, int hi) {
    a.ph_lo = lo; a.ph_hi = hi; void* kargs[] = {&a};
    hipError_t e = hipLaunchCooperativeKernel((const void*)k_fwd, dim3(grid), dim3(NTHR), kargs, LDS_BYTES, stream);
    if (e != hipSuccess) fprintf(stderr, "cooperative launch failed: %s\n", hipGetErrorString(e));
  };
  unsigned char* ws = (unsigned char*)d_ws;
  const bf16_t* P = (const bf16_t*)(ws + WS_P); bf16_t* Y = (bf16_t*)(ws + WS_Y); const float* SK = (const float*)(ws + WS_SK);
  float* R0 = (float*)(ws + WS_SCR); float* R1 = R0 + (size_t)T_ * 1024; float* R3 = R1 + (size_t)T_ * 1024;
  float* R2 = (float*)(ws + WS_XN);
  const float* const* in = (const float* const*)d_in;
  run(PH_PRO, PH_MIX_0);
  k_rg_gates<<<T_, 512, 0, stream>>>(P, in[7], in[8], in[9], in[10], in[11], in[12], in[13], R0, R1);
  k_rg_scan<<<16, 64, 0, stream>>>(R0, R1, P, Y);
  k_gla_lg<<<T_, 256, 0, stream>>>(SK, in[14], in[15], R0);
  k_gla_rec<<<8, 128, 0, stream>>>(P, R0, R2);
  k_head_norm_gate<<<T_ * 4 / 4, 256, 0, stream>>>(R2, 512, in[16], P, LDP0, 2048, Y, 512, 4);
  run(PH_GOUT_0, PH_MIX_1);
  {
    float* QN = R0; float* KN = R1; float* V = R3;
    float* BETA = (float*)(ws + WS_XN); float* G = BETA + T_ * 8;
    k_dn_prep<<<T_, 256, 0, stream>>>(P, SK, in[19], in[20], in[21], QN, KN, V, BETA, G);
    k_dn_rec<<<16, 128, 0, stream>>>(QN, KN, V, BETA, G, V);
    k_head_norm_gate<<<T_ * 8 / 4, 256, 0, stream>>>(V, D_, in[22], P, LDP1, 3072, Y, 0, 8);
  }
  run(PH_GOUT_1, PH_COUNT);
}
```

```cpp
#include <hip/hip_runtime.h>
#include <hip/hip_cooperative_groups.h>
#include <cstdio>
#include <cstdint>
namespace cg = cooperative_groups;

#define LAS __attribute__((address_space(3)))
typedef unsigned short bf16_t;
typedef short bf16x8 __attribute__((ext_vector_type(8)));
typedef float f32x4 __attribute__((ext_vector_type(4)));
typedef unsigned u32x4 __attribute__((ext_vector_type(4)));
typedef unsigned u32x2 __attribute__((ext_vector_type(2)));

constexpr int T_ = 16384, D_ = 1024, S_ = 8192;
constexpr int PAB = 2576, PC = 4112;
constexpr int LDP0 = 2560, LDP1 = 4096;
constexpr float EPS = 1e-6f;
constexpr int NTHR = 512, NWAVE = 8;
constexpr int LDS_BYTES = 151552;
constexpr int MAXROWS = 40960;

__device__ __forceinline__ float sigmoidf_(float x) { return 1.f / (1.f + __expf(-x)); }
__device__ __forceinline__ float siluf_(float x) { return x / (1.f + __expf(-x)); }
__device__ __forceinline__ float softplusf_(float x) { return x > 20.f ? x : log1pf(__expf(x)); }
__device__ __forceinline__ float gelu_tanh(float x) { return 0.5f * x * (1.f + tanhf(0.7978845608028654f * (x + 0.044715f * x * x * x))); }
__device__ __forceinline__ float wave_sum(float v) {
#pragma unroll
  for (int o = 32; o > 0; o >>= 1) v += __shfl_xor(v, o);
  return v;
}
__device__ __forceinline__ unsigned f2bf(float f) { unsigned u = __float_as_uint(f); return (u + 0x7fffu + ((u >> 16) & 1u)) >> 16; }
__device__ __forceinline__ float bf2f(unsigned h) { return __uint_as_float(h << 16); }
__device__ __forceinline__ unsigned pk2(float lo, float hi) { return f2bf(lo) | (f2bf(hi) << 16); }

namespace pg8 {
constexpr int BM = 256, BK = 64, HALF = 128, HTB = HALF * BK * 2, STAGE_BYTES = 8 * HTB, NXCD = 8, WGM = 8;
__device__ __forceinline__ int lds_byte(int r, int c) { const int st = (r >> 4) * 2 + (c >> 5), rr = r & 15, cc = c & 31, ob = rr * 64 + cc * 2; return st * 1024 + (ob ^ (((ob >> 9) & 1) << 5)); }
__device__ __forceinline__ void stage_rc(int b, int& R, int& C) { const int st = b / 1024, sb = b % 1024, swz = sb ^ (((sb >> 9) & 1) << 5); R = (st >> 1) * 16 + swz / 64; C = (st & 1) * 32 + (swz % 64) / 2; }
__device__ __forceinline__ int perm32(int rho) { const int n = rho >> 4, i = rho & 15; return 8 * (i >> 2) + 4 * n + (i & 3); }

struct Unit { int pm, pn, pc, e, slot0, cnt; };

struct StaticOrder {
  static constexpr bool GATHER = false;
  int nM, nN, nwg, G, c, K;
  __device__ void init(int M, int N, int K_, int G_, int c_) { nM = M / BM; nN = N / BM; nwg = nM * nN; G = G_; c = c_; K = K_; }
  __device__ bool next(int i, Unit& u) const {
    const long L = (long)i * G + c; if (L >= nwg) return false;
    int wgid = (int)L; { const int q = nwg / NXCD, r = nwg % NXCD, xcd = wgid % NXCD, off = wgid / NXCD; wgid = (xcd < r ? xcd * (q + 1) : r * (q + 1) + (xcd - r) * q) + off; }
    const int nig = WGM * nN, gid = wgid / nig, fm = gid * WGM, gsz = (nM - fm) < WGM ? (nM - fm) : WGM;
    u.pm = fm + ((wgid % nig) % gsz); u.pn = (wgid % nig) / gsz; u.pc = u.pn; u.e = 0; u.slot0 = 0; u.cnt = 0; return true;
  }
  __device__ __forceinline__ unsigned aoff(const Unit& u, int row, int col) const { return (unsigned)(((u.pm * BM + row) * K + col) * 2); }
};

__device__ __forceinline__ unsigned cvt_pk_bf16(float lo, float hi) { unsigned r; asm volatile("v_cvt_pk_bf16_f32 %0, %1, %2" : "=v"(r) : "v"(lo), "v"(hi)); return r; }

struct EpiBf16 {
  static constexpr bool PERM = true;
  bf16_t* O; int ldc;
  __device__ __forceinline__ void operator()(const f32x4 (&acc)[2][2][4][2], const Unit& u, int wr, int wc, int fr, int fq) const {
    const int row0 = u.pm * BM + wr * 64 + fr, col0 = u.pc * BM + wc * 32 + 8 * fq;
#pragma unroll
    for (int ai = 0; ai < 2; ++ai)
#pragma unroll
      for (int m = 0; m < 4; ++m) { bf16_t* rowp = O + (size_t)(row0 + ai * HALF + m * 16) * ldc + col0;
#pragma unroll
        for (int bj = 0; bj < 2; ++bj) { const f32x4 v0 = acc[ai][bj][m][0], v1 = acc[ai][bj][m][1];
          u32x4 w; w.x = cvt_pk_bf16(v0[0], v0[1]); w.y = cvt_pk_bf16(v0[2], v0[3]); w.z = cvt_pk_bf16(v1[0], v1[1]); w.w = cvt_pk_bf16(v1[2], v1[3]);
          *(u32x4*)(rowp + bj * HALF) = w; } }
  }
};
struct EpiResGate {
  static constexpr bool PERM = false;
  const float* res; float* out; const float* gate;
  __device__ __forceinline__ void operator()(const f32x4 (&acc)[2][2][4][2], const Unit& u, int wr, int wc, int fr, int fq) const {
#pragma unroll
    for (int ai = 0; ai < 2; ++ai)
#pragma unroll
      for (int m = 0; m < 4; ++m) { const int row = u.pm * BM + ai * HALF + wr * 64 + m * 16 + fr; const int b = row / S_;
#pragma unroll
        for (int bj = 0; bj < 2; ++bj)
#pragma unroll
          for (int n = 0; n < 2; ++n) { const int col = u.pc * BM + bj * HALF + wc * 32 + n * 16 + 4 * fq;
            const f32x4 g = *(const f32x4*)(gate + b * 6144 + col); const f32x4 r = *(const f32x4*)(res + (size_t)row * D_ + col);
            *(f32x4*)(out + (size_t)row * D_ + col) = r + g * acc[ai][bj][m][n]; } }
  }
};
struct EpiSwiglu {
  static constexpr bool PERM = true;
  bf16_t* O;
  __device__ __forceinline__ void operator()(const f32x4 (&acc)[2][2][4][2], const Unit& u, int wr, int wc, int fr, int fq) const {
    const int row0 = u.pm * BM + wr * 64 + fr, col0 = u.pc * HALF + wc * 32 + 8 * fq;
#pragma unroll
    for (int ai = 0; ai < 2; ++ai)
#pragma unroll
      for (int m = 0; m < 4; ++m) { bf16_t* rowp = O + (size_t)(row0 + ai * HALF + m * 16) * 512 + col0;
        float v[8];
#pragma unroll
        for (int n = 0; n < 2; ++n)
#pragma unroll
          for (int i = 0; i < 4; ++i) { const float g = acc[ai][0][m][n][i], up = acc[ai][1][m][n][i]; v[n * 4 + i] = g / (1.f + __expf(-g)) * up; }
        u32x4 w; w.x = cvt_pk_bf16(v[0], v[1]); w.y = cvt_pk_bf16(v[2], v[3]); w.z = cvt_pk_bf16(v[4], v[5]); w.w = cvt_pk_bf16(v[6], v[7]);
        *(u32x4*)rowp = w; }
  }
};

template <class Epi, class Sched, bool ALIGN_EPI>
__device__ __forceinline__ void gemm_phase(LAS unsigned char* lds, const bf16_t* A, const bf16_t* Bt, int K, const Sched& S, const Epi& E) {
  const int tid = threadIdx.x, wid = __builtin_amdgcn_readfirstlane(tid >> 6), lane = tid & 63, wr = wid >> 2, wc = wid & 3, fr = lane & 15, fq = lane >> 4;
  const int nt = K / BK;
  int Rr[2], Cc[2]; unsigned voffB[2];
#pragma unroll
  for (int i = 0; i < 2; ++i) { int R, C; stage_rc(tid * 16 + i * 8192, R, C); Rr[i] = R; Cc[i] = C; const int Rb = Epi::PERM ? ((R & ~31) + perm32(R & 31)) : R; voffB[i] = (unsigned)(Rb * K + C) * 2u; }
  const size_t kstep = (size_t)(BK * 2), hstep = (size_t)HALF * K * 2, tstep = 2 * hstep;
  const unsigned ldsw = (unsigned)wid * 1024u;
  const int aoff = lds_byte(wr * 64 + fr, fq * 8), boff = lds_byte(wc * 32 + fr, fq * 8);
#define PG8_SA(b, h) (((b) * 2 + (h)) * HTB)
#define PG8_SB(b, h) ((4 + (b) * 2 + (h)) * HTB)
#define PG8_STAGE(bufoff, gbase, voff) do { _Pragma("unroll") for (int _i = 0; _i < 2; ++_i) \
    __builtin_amdgcn_global_load_lds((const unsigned*)((const char*)(gbase) + (voff)[_i]), (LAS unsigned*)(lds + (bufoff) + ldsw + _i * 8192), 16, 0, 0); } while (0)
#define PG8_LDA(dst, b, h) do { _Pragma("unroll") for (int m = 0; m < 4; ++m) _Pragma("unroll") for (int k = 0; k < 2; ++k) dst[m][k] = *(const LAS bf16x8*)(lds + PG8_SA(b, h) + aoff + m * 2048 + k * 1024); } while (0)
#define PG8_LDB(dst, b, h) do { _Pragma("unroll") for (int n = 0; n < 2; ++n) _Pragma("unroll") for (int k = 0; k < 2; ++k) dst[n][k] = *(const LAS bf16x8*)(lds + PG8_SB(b, h) + boff + n * 2048 + k * 1024); } while (0)
#define PG8_MMA(ai, bj, At, Bt_) do { __builtin_amdgcn_s_setprio(1); _Pragma("unroll") for (int m = 0; m < 4; ++m) _Pragma("unroll") for (int n = 0; n < 2; ++n) _Pragma("unroll") for (int k = 0; k < 2; ++k) \
    acc[ai][bj][m][n] = __builtin_amdgcn_mfma_f32_16x16x32_bf16(Bt_[n][k], At[m][k], acc[ai][bj][m][n], 0, 0, 0); __builtin_amdgcn_s_setprio(0); } while (0)
#define PG8_WAIT_V(n) asm volatile("s_waitcnt vmcnt(" #n ")" ::: "memory")
#define PG8_WAIT_L(n) asm volatile("s_waitcnt lgkmcnt(" #n ")" ::: "memory")
#define PG8_BAR __builtin_amdgcn_s_barrier()
#define PG8_SCHED __builtin_amdgcn_sched_barrier(0)
  Unit cur, nxt; int ui = 0;
  if (!S.next(0, cur)) return;
  f32x4 acc[2][2][4][2];
#pragma unroll
  for (int a = 0; a < 2; ++a)
#pragma unroll
    for (int b = 0; b < 2; ++b)
#pragma unroll
      for (int m = 0; m < 4; ++m)
#pragma unroll
        for (int n = 0; n < 2; ++n) acc[a][b][m][n] = (f32x4){0.f, 0.f, 0.f, 0.f};
  bf16x8 At[4][2], B0[2][2], B1[2][2];
  constexpr bool GATHER = Sched::GATHER;
  unsigned cA0[2], cA1[2], nA0[2], nA1[2];
  const char* Ab = (const char*)A;
  const char* nAb = Ab;
  if constexpr (GATHER) {
#pragma unroll
    for (int i = 0; i < 2; ++i) { cA0[i] = S.aoff(cur, Rr[i], Cc[i]); cA1[i] = S.aoff(cur, HALF + Rr[i], Cc[i]); }
  } else {
#pragma unroll
    for (int i = 0; i < 2; ++i) { cA0[i] = (unsigned)(Rr[i] * K + Cc[i]) * 2u; cA1[i] = cA0[i] + (unsigned)hstep; }
    Ab = (const char*)A + (size_t)cur.pm * tstep;
  }
  const char* cB = (const char*)Bt + (size_t)cur.pn * tstep;
  PG8_STAGE(PG8_SB(0, 0), cB, voffB); PG8_STAGE(PG8_SB(0, 1), cB + hstep, voffB); PG8_STAGE(PG8_SA(0, 0), Ab, cA0); PG8_STAGE(PG8_SA(0, 1), Ab, cA1);
  if (wr == 1) PG8_BAR;
  PG8_WAIT_V(2); PG8_BAR;
  PG8_STAGE(PG8_SB(1, 0), cB + kstep, voffB); PG8_STAGE(PG8_SA(1, 0), Ab + kstep, cA0); PG8_STAGE(PG8_SB(1, 1), cB + hstep + kstep, voffB);
  PG8_WAIT_V(6); PG8_BAR;
  for (;;) {
    const bool has_next = S.next(ui + 1, nxt);
    if constexpr (GATHER) {
#pragma unroll
      for (int i = 0; i < 2; ++i) { nA0[i] = has_next ? S.aoff(nxt, Rr[i], Cc[i]) : cA0[i]; nA1[i] = has_next ? S.aoff(nxt, HALF + Rr[i], Cc[i]) : cA1[i]; }
    } else { nAb = has_next ? (const char*)A + (size_t)nxt.pm * tstep : Ab; }
    const char* nB = has_next ? (const char*)Bt + (size_t)nxt.pn * tstep : cB;
    for (int t = 0; t < nt; t += 2) {
      const bool last = (t == nt - 2);
      const char* a1 = Ab + (size_t)(t + 1) * kstep;
      const char* a2 = last ? nAb : Ab + (size_t)(t + 2) * kstep; const char* b2 = last ? nB : cB + (size_t)(t + 2) * kstep;
      const char* a3 = a2 + kstep; const char* b3 = b2 + kstep;
      PG8_LDB(B0, 0, 0); PG8_LDB(B1, 0, 1); PG8_SCHED; PG8_LDA(At, 0, 0); PG8_STAGE(PG8_SA(1, 1), a1, cA1);
      if constexpr (GATHER) { if (last) {
#pragma unroll
        for (int i = 0; i < 2; ++i) { cA0[i] = nA0[i]; cA1[i] = nA1[i]; } } }
      PG8_WAIT_V(8); PG8_WAIT_L(0); PG8_BAR; PG8_MMA(0, 0, At, B0); PG8_MMA(0, 1, At, B1); PG8_BAR; PG8_SCHED;
      PG8_LDA(At, 0, 1); PG8_STAGE(PG8_SB(0, 0), b2, voffB); PG8_STAGE(PG8_SB(0, 1), b2 + hstep, voffB); PG8_STAGE(PG8_SA(0, 0), a2, cA0);
      PG8_WAIT_V(8); PG8_WAIT_L(0); PG8_BAR; PG8_MMA(1, 0, At, B0); PG8_MMA(1, 1, At, B1); PG8_BAR; PG8_SCHED;
      PG8_LDB(B0, 1, 0); PG8_LDB(B1, 1, 1); PG8_SCHED; PG8_LDA(At, 1, 0); PG8_STAGE(PG8_SA(0, 1), a2, cA1);
      PG8_WAIT_V(8); PG8_WAIT_L(0); PG8_BAR; PG8_MMA(0, 0, At, B0); PG8_MMA(0, 1, At, B1); PG8_BAR; PG8_SCHED;
      PG8_LDA(At, 1, 1); PG8_STAGE(PG8_SB(1, 0), b3, voffB); PG8_STAGE(PG8_SB(1, 1), b3 + hstep, voffB); PG8_STAGE(PG8_SA(1, 0), a3, cA0);
      PG8_WAIT_V(8); PG8_WAIT_L(0); PG8_BAR; PG8_MMA(1, 0, At, B0); PG8_MMA(1, 1, At, B1); PG8_BAR; PG8_SCHED;
    }
    if constexpr (ALIGN_EPI) { if (wr == 0) PG8_BAR; }
    E(acc, cur, wr, wc, fr, fq);
    if (!has_next) break;
#pragma unroll
    for (int a = 0; a < 2; ++a)
#pragma unroll
      for (int b = 0; b < 2; ++b)
#pragma unroll
        for (int m = 0; m < 4; ++m)
#pragma unroll
          for (int n = 0; n < 2; ++n) acc[a][b][m][n] = (f32x4){0.f, 0.f, 0.f, 0.f};
    cur = nxt; cB = nB; ++ui;
    if constexpr (!GATHER) Ab = nAb;
    if constexpr (ALIGN_EPI) { if (wr == 1) PG8_BAR; }
  }
  PG8_WAIT_V(0);
  if constexpr (!ALIGN_EPI) { if (wr == 0) PG8_BAR; }
  PG8_BAR;
#undef PG8_SA
#undef PG8_SB
#undef PG8_STAGE
#undef PG8_LDA
#undef PG8_LDB
#undef PG8_MMA
#undef PG8_WAIT_V
#undef PG8_WAIT_L
#undef PG8_BAR
#undef PG8_SCHED
}
}

struct Args {
  const float* in[32];
  float* out;
  unsigned char* ws;
  int ph_lo, ph_hi;
};
constexpr size_t MiB = 1u << 20;
constexpr size_t WS_CTL = 0;
constexpr size_t WS_MOD = 64 * 1024;
constexpr size_t WS_TOK = 1 * MiB;
constexpr size_t WS_LIST = 2 * MiB;
constexpr size_t WS_SK = 4 * MiB;
constexpr size_t WS_WIN0 = 6 * MiB;
constexpr size_t WS_WOUT0 = 11 * MiB;
constexpr size_t WS_WIN1 = 13 * MiB;
constexpr size_t WS_WOUT1 = 21 * MiB;
constexpr size_t WS_W13 = 24 * MiB;
constexpr size_t WS_W2 = 88 * MiB;
constexpr size_t WS_XN = 120 * MiB;
constexpr size_t WS_Y = 152 * MiB;
constexpr size_t WS_P = 184 * MiB;
constexpr size_t WS_HMID = WS_P;
constexpr size_t WS_YB = WS_P + 40 * MiB;
constexpr size_t WS_SCR = 312 * MiB;
constexpr size_t WS_END = 504 * MiB;
constexpr size_t WS_GW = 512 * 1024;
constexpr size_t WS_HLOC = WS_SCR;
constexpr size_t WS_CP = WS_SCR + 32 * MiB;
constexpr size_t WS_DST = WS_SCR + 64 * MiB;
constexpr size_t WS_STG = WS_SCR + 96 * MiB;
constexpr size_t WS_OLG = WS_SCR + 112 * MiB;
constexpr size_t WS_QG = WS_SCR + 128 * MiB;
constexpr size_t WS_DEC = WS_SCR + 136 * MiB;
constexpr size_t WS_CAR = WS_SCR + 137 * MiB;
constexpr size_t WS_AC = WS_SCR;
constexpr size_t WS_BCT = WS_SCR + 64 * MiB;
constexpr size_t WS_QH = WS_SCR + 128 * MiB;
constexpr size_t WS_OLOC = WS_SCR + 160 * MiB;

struct Frame {
  LAS unsigned char* lds;
  int tid, lane, wave, G, bid;
  float* out; unsigned char* ws;
};

__device__ __forceinline__ void transpose_item(const float* W, int ldw, int K, bf16_t* WT, int k0, int n0, int row0, LAS float* scr, int lane) {
#pragma unroll 8
  for (int i = 0; i < 32; ++i) { const int kk = 2 * i + (lane >> 5); scr[kk * 33 + (lane & 31)] = W[(size_t)(k0 + kk) * ldw + n0 + (lane & 31)]; }
  asm volatile("s_waitcnt lgkmcnt(0)" ::: "memory");
  const int c = lane & 7;
#pragma unroll
  for (int j = 0; j < 4; ++j) { const int n = (lane >> 3) + 8 * j; const LAS float* s = scr + (8 * c) * 33 + n;
    u32x4 o; o.x = pk2(s[0 * 33], s[1 * 33]); o.y = pk2(s[2 * 33], s[3 * 33]); o.z = pk2(s[4 * 33], s[5 * 33]); o.w = pk2(s[6 * 33], s[7 * 33]);
    *(u32x4*)(WT + (size_t)(row0 + n) * K + k0 + 8 * c) = o; }
  asm volatile("s_waitcnt lgkmcnt(0)" ::: "memory");
}
__device__ __forceinline__ void convert_moe(Frame& F, const Args& A, int layer) {
  LAS float* scr = (LAS float*)(F.lds + F.wave * 16384);
  const int gw = F.bid * NWAVE + F.wave, NGW = F.G * NWAVE;
  for (int it = gw; it < 32 * 768; it += NGW) {
    const int e = it / 768; int r = it % 768; const int le = layer * 32 + e;
    if (r < 512) {
      const int which = r >> 8, rr = r & 255, kb = rr / 16, nb = rr % 16, n0 = nb * 32;
      const float* W = (which ? A.in[29] : A.in[28]) + (size_t)le * 1024 * 512;
      transpose_item(W, 512, 1024, (bf16_t*)(F.ws + WS_W13) + (size_t)e * 1024 * 1024, kb * 64, n0, (n0 >> 7) * 256 + (n0 & 127) + which * 128, scr, F.lane);
    } else {
      const int rr = r - 512, kb = rr / 32, nb = rr % 32;
      transpose_item(A.in[30] + (size_t)le * 512 * 1024, 1024, 512, (bf16_t*)(F.ws + WS_W2) + (size_t)e * 1024 * 512, kb * 64, nb * 32, nb * 32, scr, F.lane);
    }
  }
}
__device__ __forceinline__ void ph_prologue(Frame& F, const Args& A) {
  LAS float* scr = (LAS float*)(F.lds + F.wave * 16384);
  const int gw = F.bid * NWAVE + F.wave, NGW = F.G * NWAVE;
  if (F.bid == 0 && F.tid < 64) ((int*)(F.ws + WS_CTL))[F.tid] = 0;
  constexpr int I_IN0 = 16 * 80, I_OUT = 16 * 32, I_IN1 = 16 * 128;
  constexpr int NIT = I_IN0 + I_OUT + I_IN1 + I_OUT;
  for (int it = gw; it < NIT; it += NGW) {
    int r = it;
    if (r < I_IN0) { const int kb = r / 80, nb = r % 80; transpose_item(A.in[6], PAB, 1024, (bf16_t*)(F.ws + WS_WIN0), kb * 64, nb * 32, nb * 32, scr, F.lane); continue; } r -= I_IN0;
    if (r < I_OUT) { const int kb = r / 32, nb = r % 32; transpose_item(A.in[17], 1024, 1024, (bf16_t*)(F.ws + WS_WOUT0), kb * 64, nb * 32, nb * 32, scr, F.lane); continue; } r -= I_OUT;
    if (r < I_IN1) { const int kb = r / 128, nb = r % 128; transpose_item(A.in[18], PC, 1024, (bf16_t*)(F.ws + WS_WIN1), kb * 64, nb * 32, nb * 32, scr, F.lane); continue; } r -= I_IN1;
    { const int kb = r / 32, nb = r % 32; transpose_item(A.in[23], 1024, 1024, (bf16_t*)(F.ws + WS_WOUT1), kb * 64, nb * 32, nb * 32, scr, F.lane); }
  }
  {
    bf16_t* WAT = (bf16_t*)(F.ws + WS_GW);
    for (int idx = F.bid * NTHR + F.tid; idx < 65536; idx += F.G * NTHR) { const int mtx = idx >> 15, h = (idx >> 12) & 7, j = (idx >> 6) & 63, i = idx & 63;
      WAT[idx] = (bf16_t)f2bf((mtx ? A.in[11] : A.in[9])[h * 4096 + i * 64 + j]); }
  }
  const float* c = A.in[1]; const float* w_ada = A.in[4]; const float* b_ada = A.in[5]; float* mod = (float*)(F.ws + WS_MOD);
  for (int un = gw; un < 384; un += NGW) {
    const int l = un / 192, n0 = (un % 192) * 32, kg = F.lane >> 3, cq = F.lane & 7;
    f32x4 a0 = {0.f, 0.f, 0.f, 0.f}, a1 = {0.f, 0.f, 0.f, 0.f};
    const float* w = w_ada + (size_t)l * 1024 * 6144 + n0 + cq * 4;
#pragma unroll 4
    for (int k = kg * 128; k < kg * 128 + 128; ++k) { const f32x4 wv = *(const f32x4*)(w + (size_t)k * 6144); const float c0 = siluf_(c[k]), c1 = siluf_(c[1024 + k]); a0 += wv * c0; a1 += wv * c1; }
#pragma unroll
    for (int o = 8; o < 64; o <<= 1)
#pragma unroll
      for (int i = 0; i < 4; ++i) { a0[i] += __shfl_xor(a0[i], o); a1[i] += __shfl_xor(a1[i], o); }
    if (kg == 0) { const f32x4 bb = *(const f32x4*)(b_ada + l * 6144 + n0 + cq * 4);
      *(f32x4*)(mod + (l * 2 + 0) * 6144 + n0 + cq * 4) = a0 + bb; *(f32x4*)(mod + (l * 2 + 1) * 6144 + n0 + cq * 4) = a1 + bb; }
  }
}

template <int MODE>
__device__ __forceinline__ void ph_norm(Frame& F, const Args& A, int l) {
  constexpr bool COMBINE = (MODE == 1 || MODE == 3);
  constexpr int NS = (MODE == 2) ? 36 : (MODE == 3 ? 0 : 16);
  constexpr int NSP = (MODE == 2) ? 36 : 20;
  LAS float* wl = (LAS float*)F.lds;
  LAS int* tb = (LAS int*)(F.lds + 147456);
  const float* mod = (const float*)(F.ws + WS_MOD);
  if (NS > 0) {
    for (int idx = F.tid; idx < 1024 * NS; idx += NTHR) {
      const int k = idx / NS, n = idx % NS; float v;
      if (MODE == 2) v = n < 4 ? A.in[24][(size_t)l * 4096 + k * 4 + n] : A.in[26][(size_t)l * 32768 + k * 32 + (n - 4)];
      else v = MODE == 0 ? A.in[6][(size_t)k * PAB + 2560 + n] : A.in[18][(size_t)k * PC + 4096 + n];
      const int rho = ((k >> 2) & 63) + 64 * (((k >> 8) << 2) + (k & 3));
      wl[rho * NSP + n] = v;
    }
  }
  const int lc = (MODE == 1) ? 0 : 1;
  if (COMBINE) { if (F.tid == 0) { const int* cnt = (const int*)(F.ws + WS_CTL) + lc * 32; int acc = 0;
#pragma unroll 1
    for (int e = 0; e < 32; ++e) { tb[e] = acc; acc += (cnt[e] + 255) >> 8; } } }
  __syncthreads();
  const float* hin = (MODE == 0) ? A.in[0] : F.out;
  const float* gvec = (MODE == 3) ? A.in[31] : (MODE == 2 ? A.in[3] + l * D_ : A.in[2] + l * D_);
  const float* modl = mod + l * 2 * 6144;
  const int shp = (MODE == 2) ? 3 : 0, scp = (MODE == 2) ? 4 : 1;
  const int* tok_e = (const int*)(F.ws + WS_TOK); const int* tok_s = tok_e + 2 * T_; const float* tok_w = (const float*)(tok_s + 2 * T_);
  const bf16_t* yb = (const bf16_t*)(F.ws + WS_YB);
  bf16_t* xn = (bf16_t*)(F.ws + WS_XN);
  const int gw = F.bid * NWAVE + F.wave, NGW = F.G * NWAVE, lane = F.lane;
  constexpr int RPW = 2;
  for (int it = gw; it < T_ / RPW; it += NGW) {
    float u[RPW][16];
#pragma unroll
    for (int r = 0; r < RPW; ++r) {
      const int row = it * RPW + r, b = row / S_;
      const float* hr = hin + (size_t)row * D_;
      float v[16];
#pragma unroll
      for (int j = 0; j < 4; ++j) { const f32x4 x = *(const f32x4*)(hr + lane * 4 + 256 * j); v[4*j] = x[0]; v[4*j+1] = x[1]; v[4*j+2] = x[2]; v[4*j+3] = x[3]; }
      if (COMBINE) {
        const int e0 = tok_e[row * 2], e1 = tok_e[row * 2 + 1];
        const int r0 = tb[e0] * 256 + tok_s[row * 2], r1 = tb[e1] * 256 + tok_s[row * 2 + 1];
        const float w0 = tok_w[row * 2], w1 = tok_w[row * 2 + 1];
        const float* g2 = mod + (lc * 2 + b) * 6144 + 5 * 1024;
#pragma unroll
        for (int j = 0; j < 4; ++j) {
          const u32x2 y0 = *(const u32x2*)(yb + (size_t)r0 * D_ + lane * 4 + 256 * j), y1 = *(const u32x2*)(yb + (size_t)r1 * D_ + lane * 4 + 256 * j);
          const f32x4 g = *(const f32x4*)(g2 + lane * 4 + 256 * j);
          v[4*j]   += g[0] * (w0 * bf2f(y0.x & 0xffffu) + w1 * bf2f(y1.x & 0xffffu));
          v[4*j+1] += g[1] * (w0 * bf2f(y0.x >> 16) + w1 * bf2f(y1.x >> 16));
          v[4*j+2] += g[2] * (w0 * bf2f(y0.y & 0xffffu) + w1 * bf2f(y1.y & 0xffffu));
          v[4*j+3] += g[3] * (w0 * bf2f(y0.y >> 16) + w1 * bf2f(y1.y >> 16));
        }
        if (MODE == 1) {
#pragma unroll
          for (int j = 0; j < 4; ++j) *(f32x4*)(F.out + (size_t)row * D_ + lane * 4 + 256 * j) = (f32x4){v[4*j], v[4*j+1], v[4*j+2], v[4*j+3]};
        }
      }
      float ss = 0.f;
#pragma unroll
      for (int i = 0; i < 16; ++i) ss += v[i] * v[i];
      ss = wave_sum(ss);
      const float rstd = rsqrtf(ss * (1.f / D_) + EPS);
#pragma unroll
      for (int j = 0; j < 4; ++j) {
        const f32x4 g = *(const f32x4*)(gvec + lane * 4 + 256 * j);
        f32x4 y = {v[4*j] * rstd * g[0], v[4*j+1] * rstd * g[1], v[4*j+2] * rstd * g[2], v[4*j+3] * rstd * g[3]};
        if (MODE != 3) { const f32x4 sc = *(const f32x4*)(modl + b * 6144 + scp * 1024 + lane * 4 + 256 * j), sh = *(const f32x4*)(modl + b * 6144 + shp * 1024 + lane * 4 + 256 * j); y = y * (1.f + sc) + sh; }
        u[r][4*j] = y[0]; u[r][4*j+1] = y[1]; u[r][4*j+2] = y[2]; u[r][4*j+3] = y[3];
        if (MODE == 3) *(f32x4*)(F.out + (size_t)row * D_ + lane * 4 + 256 * j) = y;
        else { u32x2 p; p.x = pk2(y[0], y[1]); p.y = pk2(y[2], y[3]); *(u32x2*)(xn + (size_t)row * D_ + lane * 4 + 256 * j) = p; }
      }
    }
    if (MODE == 0 || MODE == 1) {
#pragma unroll 1
      for (int cgp = 0; cgp < 4; ++cgp) {
        f32x4 a[RPW];
#pragma unroll
        for (int r = 0; r < RPW; ++r) a[r] = (f32x4){0.f, 0.f, 0.f, 0.f};
#pragma unroll
        for (int kk = 0; kk < 16; ++kk) {
          const f32x4 w = *(const LAS f32x4*)(wl + (lane + 64 * kk) * NSP + cgp * 4);
#pragma unroll
          for (int r = 0; r < RPW; ++r) a[r] += w * u[r][kk];
        }
#pragma unroll
        for (int r = 0; r < RPW; ++r)
#pragma unroll
          for (int i = 0; i < 4; ++i) a[r][i] = wave_sum(a[r][i]);
        if (lane < RPW) { const f32x4 v = lane == 0 ? a[0] : a[1]; *(f32x4*)((float*)(F.ws + WS_SK) + (size_t)(it * RPW + lane) * 16 + cgp * 4) = v; }
      }
    }
    if (MODE == 2) {
      f32x4 ag[RPW];
#pragma unroll
      for (int r = 0; r < RPW; ++r) ag[r] = (f32x4){0.f, 0.f, 0.f, 0.f};
#pragma unroll
      for (int kk = 0; kk < 16; ++kk) {
        const f32x4 w = *(const LAS f32x4*)(wl + (lane + 64 * kk) * NSP);
#pragma unroll
        for (int r = 0; r < RPW; ++r) ag[r] += w * u[r][kk];
      }
      const float* bg = A.in[25] + l * 4; const float* br = A.in[27] + l * 32;
#pragma unroll
      for (int r = 0; r < RPW; ++r) {
        const int row = it * RPW + r;
        float g4[4];
#pragma unroll
        for (int i = 0; i < 4; ++i) g4[i] = wave_sum(ag[r][i]) + bg[i];
        int gi = 0; float gm = g4[0];
#pragma unroll
        for (int i = 1; i < 4; ++i) if (g4[i] > gm) { gm = g4[i]; gi = i; }
        float se = 0.f;
#pragma unroll
        for (int i = 0; i < 4; ++i) se += __expf(g4[i] - gm);
        const float pg = 1.f / se;
        f32x4 e0v = {0.f, 0.f, 0.f, 0.f}, e1v = {0.f, 0.f, 0.f, 0.f};
#pragma unroll
        for (int kk = 0; kk < 16; ++kk) {
          const LAS float* wp = wl + (lane + 64 * kk) * NSP + 4 + gi * 8;
          e0v += *(const LAS f32x4*)wp * u[r][kk]; e1v += *(const LAS f32x4*)(wp + 4) * u[r][kk];
        }
        float le[8];
#pragma unroll
        for (int i = 0; i < 4; ++i) { le[i] = wave_sum(e0v[i]) + br[gi * 8 + i]; le[4 + i] = wave_sum(e1v[i]) + br[gi * 8 + 4 + i]; }
        float m0 = -3.4e38f, m1 = -3.4e38f; int e0 = 0, e1 = 0;
#pragma unroll
        for (int i = 0; i < 8; ++i) { const float x = le[i];
          if (x > m0) { m1 = m0; e1 = e0; m0 = x; e0 = i; } else if (x > m1) { m1 = x; e1 = i; } }
        const float p1 = __expf(m1 - m0), w0 = pg / (1.f + p1), w1 = pg * p1 / (1.f + p1);
        const int E0 = gi * 8 + e0, E1 = gi * 8 + e1;
        if (lane == 0) {
          int* cnt = (int*)(F.ws + WS_CTL) + l * 32; int* list = (int*)(F.ws + WS_LIST);
          const int s0 = atomicAdd(&cnt[E0], 1), s1 = atomicAdd(&cnt[E1], 1);
          list[E0 * T_ + s0] = row; list[E1 * T_ + s1] = row;
          int* te = (int*)(F.ws + WS_TOK); int* ts = te + 2 * T_; float* tw = (float*)(ts + 2 * T_);
          te[row * 2] = E0; te[row * 2 + 1] = E1; ts[row * 2] = s0; ts[row * 2 + 1] = s1; tw[row * 2] = w0; tw[row * 2 + 1] = w1;
        }
      }
    }
  }
}

template <bool GATHER_> struct MoeSched {
  static constexpr bool GATHER = GATHER_;
  const LAS int* tb; const LAS int* cn; const int* list; int G, c, K, ntot;
  __device__ bool next(int i, pg8::Unit& u) const {
    const int L = i * G + c; if (L >= ntot * 4) return false;
    const int rt = L >> 2, pc = L & 3; const int e = tb[80 + rt];
    u.pm = rt; u.pc = pc; u.pn = e * 4 + pc; u.e = e; u.slot0 = (rt - tb[e]) * 256; u.cnt = cn[e]; return true;
  }
  __device__ __forceinline__ unsigned aoff(const pg8::Unit& u, int row, int col) const {
    if (GATHER) { const int s = u.slot0 + row; const int tok = s < u.cnt ? list[u.e * T_ + s] : 0; return (unsigned)((tok * K + col) * 2); }
    return (unsigned)(((u.pm * 256 + row) * K + col) * 2);
  }
};
__device__ __forceinline__ void moe_tables(Frame& F, int l, LAS int* tb, LAS int* cn) {
  if (F.tid == 0) { const int* cnt = (const int*)(F.ws + WS_CTL) + l * 32; int acc = 0;
#pragma unroll 1
    for (int e = 0; e < 32; ++e) { const int c = cnt[e]; tb[e] = acc; cn[e] = c; const int nt = (c + 255) >> 8;
#pragma unroll 1
      for (int j = 0; j < nt; ++j) tb[80 + acc + j] = e;
      acc += nt; }
    tb[32] = acc; }
  __syncthreads();
}


__device__ __forceinline__ f32x4 mfma16(bf16x8 a, bf16x8 b, f32x4 c) { return __builtin_amdgcn_mfma_f32_16x16x32_bf16(a, b, c, 0, 0, 0); }
template <int K>
__device__ __forceinline__ f32x4 mma_tile(const LAS bf16_t* A, int lda, const LAS bf16_t* Bt, int ldb, int lane, f32x4 acc) {
  const int r = lane & 15, q = lane >> 4;
#pragma unroll
  for (int kb = 0; kb < K / 32; ++kb) {
    const bf16x8 a = *(const LAS bf16x8*)(A + r * lda + kb * 32 + q * 8);
    const bf16x8 b = *(const LAS bf16x8*)(Bt + r * ldb + kb * 32 + q * 8);
    acc = mfma16(a, b, acc);
  }
  return acc;
}
__device__ __forceinline__ u32x2 pack4(f32x4 v) { u32x2 p; p.x = pk2(v[0], v[1]); p.y = pk2(v[2], v[3]); return p; }
__device__ __forceinline__ f32x4 unpack4(u32x2 p) { return (f32x4){bf2f(p.x & 0xffffu), bf2f(p.x >> 16), bf2f(p.y & 0xffffu), bf2f(p.y >> 16)}; }

__device__ __forceinline__ void ph_dn1(Frame& F, const Args& A) {
  LAS bf16_t* Kt = (LAS bf16_t*)(F.lds + 0);
  LAS bf16_t* Qt = (LAS bf16_t*)(F.lds + 17408);
  LAS bf16_t* ATT = (LAS bf16_t*)(F.lds + 34816);
  LAS bf16_t* KTt = (LAS bf16_t*)(F.lds + 44032);
  LAS float* Lm = (LAS float*)(F.lds + 62464);
  LAS float* Vs = (LAS float*)(F.lds + 79872);
  LAS bf16_t* UWt = (LAS bf16_t*)(F.lds + 62464);
  LAS float* CW = (LAS float*)(F.lds + 112640);
  LAS float* SC = (LAS float*)(F.lds + 118784);
  const bf16_t* P = (const bf16_t*)(F.ws + WS_P); const float* SK = (const float*)(F.ws + WS_SK);
  const float* conv_w = A.in[19];
  const int tid = F.tid, lane = F.lane, wave = F.wave;
  for (int u = F.bid; u < 2048; u += F.G) {
    const int h = u & 7, c = (u >> 3) & 127, b = u >> 10;
    const int t0 = b * S_ + c * 64;
    for (int i = tid; i < 1536; i += NTHR) { const int x = i >> 9, j = (i >> 7) & 3, ch = i & 127; CW[i] = conv_w[j * 3072 + x * 1024 + h * 128 + ch]; }
    if (tid < 64) {
      const float bl = SK[(size_t)(t0 + tid) * 16 + h], al = SK[(size_t)(t0 + tid) * 16 + 8 + h];
      float g = -__expf(A.in[20][h]) * softplusf_(al + A.in[21][h]);
#pragma unroll
      for (int d = 1; d < 64; d <<= 1) { const float o = __shfl_up(g, d); if (lane >= d) g += o; }
      SC[tid] = sigmoidf_(bl); SC[64 + tid] = g;
    }
    __syncthreads();
    {
      const int tok = tid >> 3, part = tid & 7, tl = c * 64 + tok;
      float ss[2];
#pragma unroll
      for (int x = 0; x < 3; ++x) {
        float acc[16];
#pragma unroll
        for (int i = 0; i < 16; ++i) acc[i] = 0.f;
#pragma unroll
        for (int j = 0; j < 4; ++j) {
          if (tl - 3 + j >= 0) {
            const bf16_t* src = P + (size_t)(t0 + tok - 3 + j) * LDP1 + x * 1024 + h * 128 + part * 16;
            const u32x4 v0 = *(const u32x4*)src, v1 = *(const u32x4*)(src + 8);
            const LAS float* w = CW + (x * 4 + j) * 128 + part * 16;
            const unsigned vv[8] = {v0.x, v0.y, v0.z, v0.w, v1.x, v1.y, v1.z, v1.w};
#pragma unroll
            for (int i = 0; i < 8; ++i) { acc[2*i] += w[2*i] * bf2f(vv[i] & 0xffffu); acc[2*i+1] += w[2*i+1] * bf2f(vv[i] >> 16); }
          }
        }
        float s2 = 0.f;
#pragma unroll
        for (int i = 0; i < 16; ++i) { acc[i] = siluf_(acc[i]); s2 += acc[i] * acc[i]; }
        if (x < 2) {
          s2 += __shfl_xor(s2, 1); s2 += __shfl_xor(s2, 2); s2 += __shfl_xor(s2, 4);
          float sc = rsqrtf(s2 + EPS); if (x == 0) sc *= 0.08838834764831845f;
          LAS bf16_t* dst = (x == 0 ? Qt : Kt) + tok * 136 + part * 16;
          u32x4 o0, o1;
          o0.x = pk2(acc[0] * sc, acc[1] * sc); o0.y = pk2(acc[2] * sc, acc[3] * sc); o0.z = pk2(acc[4] * sc, acc[5] * sc); o0.w = pk2(acc[6] * sc, acc[7] * sc);
          o1.x = pk2(acc[8] * sc, acc[9] * sc); o1.y = pk2(acc[10] * sc, acc[11] * sc); o1.z = pk2(acc[12] * sc, acc[13] * sc); o1.w = pk2(acc[14] * sc, acc[15] * sc);
          *(LAS u32x4*)dst = o0; *(LAS u32x4*)(dst + 8) = o1;
        } else {
          LAS float* dst = Vs + tok * 128 + part * 16;
#pragma unroll
          for (int i = 0; i < 4; ++i) *(LAS f32x4*)(dst + 4 * i) = (f32x4){acc[4*i], acc[4*i+1], acc[4*i+2], acc[4*i+3]};
        }
        (void)ss;
      }
    }
    __syncthreads();
    {
      const int q = lane >> 4, cc = lane & 15;
#pragma unroll 1
      for (int m = 0; m < 4; ++m) {
        const int id = wave * 4 + m, mat = id >> 4, ti = (id >> 2) & 3, tj = id & 3;
        f32x4 acc = {0.f, 0.f, 0.f, 0.f};
        if (tj <= ti) acc = mma_tile<128>((mat == 0 ? Kt : Qt) + ti * 16 * 136, 136, Kt + tj * 16 * 136, 136, lane, acc);
        const int j = tj * 16 + cc; const float gj = SC[64 + j];
#pragma unroll
        for (int r = 0; r < 4; ++r) {
          const int i = ti * 16 + 4 * q + r; const float d = __expf(SC[64 + i] - gj);
          if (mat == 0) Lm[i * 68 + j] = (i > j) ? SC[i] * acc[r] * d : 0.f;
          else ATT[i * 72 + j] = (bf16_t)f2bf((i >= j) ? acc[r] * d : 0.f);
        }
      }
    }
    __syncthreads();
    float x[64];
    if (tid < 256) {
      const int n = tid;
#pragma unroll
      for (int i = 0; i < 64; ++i) {
        float a = (n < 128) ? SC[i] * Vs[i * 128 + n] : SC[i] * __expf(SC[64 + i]) * bf2f(Kt[i * 136 + (n - 128)]);
#pragma unroll
        for (int j4 = 0; j4 < (i + 3) / 4; ++j4) {
          const f32x4 l = *(const LAS f32x4*)(Lm + i * 68 + 4 * j4);
#pragma unroll
          for (int jj = 0; jj < 4; ++jj) if (4 * j4 + jj < i) a -= l[jj] * x[4 * j4 + jj];
        }
        asm volatile("" : "+v"(a) :: "memory");
        x[i] = a;
      }
    } else {
      const float gl = SC[64 + 63];
      for (int e = tid - 256; e < 8192; e += 256) { const int tok = e >> 7, dk = e & 127; KTt[dk * 72 + tok] = (bf16_t)f2bf(bf2f(Kt[tok * 136 + dk]) * __expf(gl - SC[64 + tok])); }
    }
    __syncthreads();
    if (tid < 256) {
#pragma unroll
      for (int i8 = 0; i8 < 8; ++i8) { u32x4 o; o.x = pk2(x[8*i8], x[8*i8+1]); o.y = pk2(x[8*i8+2], x[8*i8+3]); o.z = pk2(x[8*i8+4], x[8*i8+5]); o.w = pk2(x[8*i8+6], x[8*i8+7]); *(LAS u32x4*)(UWt + tid * 72 + 8 * i8) = o; }
    }
    __syncthreads();
    {
      const int q = lane >> 4, cc = lane & 15;
      bf16_t* OL = (bf16_t*)(F.ws + WS_OLOC); bf16_t* QH = (bf16_t*)(F.ws + WS_QH) + (size_t)u * 64 * 128;
      bf16_t* BCT = (bf16_t*)(F.ws + WS_BCT) + (size_t)u * 128 * 128; bf16_t* AC = (bf16_t*)(F.ws + WS_AC) + (size_t)u * 128 * 128;
      const float egl = __expf(SC[64 + 63]);
#pragma unroll 1
      for (int m = 0; m < 24; ++m) {
        const int id = wave + 8 * m;
        f32x4 acc = {0.f, 0.f, 0.f, 0.f};
        if (id < 32) {
          const int tdv = id >> 2, tt = id & 3;
          acc = mma_tile<64>(UWt + tdv * 16 * 72, 72, ATT + tt * 16 * 72, 72, lane, acc);
          *(u32x2*)(OL + (size_t)(t0 + tt * 16 + cc) * D_ + h * 128 + tdv * 16 + 4 * q) = pack4(acc);
        } else if (id < 64) {
          const int tdk = (id - 32) >> 2, tt = id & 3, tok = tt * 16 + cc;
          acc = mma_tile<64>(UWt + (128 + tdk * 16) * 72, 72, ATT + tt * 16 * 72, 72, lane, acc);
          const u32x2 qv = *(const LAS u32x2*)(Qt + tok * 136 + tdk * 16 + 4 * q);
          const float eg = __expf(SC[64 + tok]);
          *(u32x2*)(QH + tok * 128 + tdk * 16 + 4 * q) = pack4(unpack4(qv) * eg - acc);
        } else if (id < 128) {
          const int tdk = (id - 64) >> 3, tdv = id & 7;
          acc = mma_tile<64>(KTt + tdk * 16 * 72, 72, UWt + tdv * 16 * 72, 72, lane, acc);
          *(u32x2*)(BCT + (tdv * 16 + cc) * 128 + tdk * 16 + 4 * q) = pack4(acc);
        } else {
          const int tn = (id - 128) >> 3, tm = id & 7, mm = tm * 16 + cc;
          acc = mma_tile<64>(UWt + (128 + tn * 16) * 72, 72, KTt + tm * 16 * 72, 72, lane, acc);
          f32x4 v;
#pragma unroll
          for (int r = 0; r < 4; ++r) v[r] = ((tn * 16 + 4 * q + r) == mm ? egl : 0.f) - acc[r];
          *(u32x2*)(AC + mm * 128 + tn * 16 + 4 * q) = pack4(v);
        }
      }
    }
    __syncthreads();
  }
}

__device__ __forceinline__ void ph_dn2(Frame& F) {
  if (F.bid >= 16) return;
  const int b = F.bid >> 3, h = F.bid & 7, tid = F.tid, lane = F.lane, js = F.wave, q = lane >> 4, cc = lane & 15;
  LAS bf16_t* Ab = (LAS bf16_t*)F.lds;
  const bf16_t* AC = (const bf16_t*)(F.ws + WS_AC); bf16_t* BCT = (bf16_t*)(F.ws + WS_BCT);
  f32x4 S[8];
#pragma unroll
  for (int r = 0; r < 8; ++r) S[r] = (f32x4){0.f, 0.f, 0.f, 0.f};
  u32x4 an[4]; u32x2 bc[8], bn[8];
  { const size_t u = (size_t)(b * 128 + 0) * 8 + h;
#pragma unroll
    for (int m = 0; m < 4; ++m) { const int p = tid + 512 * m, row = p >> 4, c16 = p & 15; *(LAS u32x4*)(Ab + row * 136 + c16 * 8) = *(const u32x4*)(AC + u * 16384 + row * 128 + c16 * 8); }
#pragma unroll
    for (int r = 0; r < 8; ++r) bc[r] = *(const u32x2*)(BCT + u * 16384 + (16 * js + cc) * 128 + 16 * r + 4 * q);
  }
  __syncthreads();
#pragma unroll 1
  for (int c = 0; c < 128; ++c) {
    const size_t u = (size_t)(b * 128 + c) * 8 + h;
    LAS bf16_t* cur = Ab + (c & 1) * (128 * 136); LAS bf16_t* nxt = Ab + ((c + 1) & 1) * (128 * 136);
    if (c + 1 < 128) {
#pragma unroll
      for (int m = 0; m < 4; ++m) { const int p = tid + 512 * m, row = p >> 4, c16 = p & 15; an[m] = *(const u32x4*)(AC + (u + 8) * 16384 + row * 128 + c16 * 8); }
#pragma unroll
      for (int r = 0; r < 8; ++r) bn[r] = *(const u32x2*)(BCT + (u + 8) * 16384 + (16 * js + cc) * 128 + 16 * r + 4 * q);
    }
    u32x2 sp[8]; f32x4 Sn[8];
#pragma unroll
    for (int r = 0; r < 8; ++r) { sp[r] = pack4(S[r]); Sn[r] = unpack4(bc[r]); }
#pragma unroll
    for (int kb = 0; kb < 4; ++kb) {
      u32x4 bw; bw.x = sp[2 * kb].x; bw.y = sp[2 * kb].y; bw.z = sp[2 * kb + 1].x; bw.w = sp[2 * kb + 1].y;
      const bf16x8 bfr = __builtin_bit_cast(bf16x8, bw);
#pragma unroll
      for (int r = 0; r < 8; ++r) {
        const u32x2 lo = *(const LAS u32x2*)(cur + (16 * r + cc) * 136 + 32 * kb + 4 * q), hi = *(const LAS u32x2*)(cur + (16 * r + cc) * 136 + 32 * kb + 16 + 4 * q);
        u32x4 aw; aw.x = lo.x; aw.y = lo.y; aw.z = hi.x; aw.w = hi.y;
        Sn[r] = mfma16(__builtin_bit_cast(bf16x8, aw), bfr, Sn[r]);
      }
    }
#pragma unroll
    for (int r = 0; r < 8; ++r) { *(u32x2*)(BCT + u * 16384 + (16 * js + cc) * 128 + 16 * r + 4 * q) = sp[r]; S[r] = Sn[r]; }
    if (c + 1 < 128) {
#pragma unroll
      for (int m = 0; m < 4; ++m) { const int p = tid + 512 * m, row = p >> 4, c16 = p & 15; *(LAS u32x4*)(nxt + row * 136 + c16 * 8) = an[m]; }
#pragma unroll
      for (int r = 0; r < 8; ++r) bc[r] = bn[r];
    }
    __syncthreads();
  }
}

__device__ __forceinline__ void ph_dn3(Frame& F, const Args& A) {
  const int lane = F.lane, q = lane >> 4, cc = lane & 15, tt = F.wave & 3;
  const bf16_t* ST = (const bf16_t*)(F.ws + WS_BCT); const bf16_t* QH = (const bf16_t*)(F.ws + WS_QH); const bf16_t* OL = (const bf16_t*)(F.ws + WS_OLOC);
  const bf16_t* P = (const bf16_t*)(F.ws + WS_P); bf16_t* Y = (bf16_t*)(F.ws + WS_Y); const float* gn = A.in[22];
  for (int up = F.bid; up < 1024; up += F.G) {
    const int u = up * 2 + (F.wave >> 2), h = u & 7, c = (u >> 3) & 127, b = u >> 10;
    const size_t t = (size_t)b * S_ + c * 64 + tt * 16 + cc;
    bf16x8 bq[4];
#pragma unroll
    for (int kb = 0; kb < 4; ++kb) bq[kb] = *(const bf16x8*)(QH + (size_t)u * 8192 + (tt * 16 + cc) * 128 + kb * 32 + q * 8);
    f32x4 acc[8]; float ss = 0.f;
#pragma unroll
    for (int td = 0; td < 8; ++td) {
      acc[td] = unpack4(*(const u32x2*)(OL + t * D_ + h * 128 + td * 16 + 4 * q));
#pragma unroll
      for (int kb = 0; kb < 4; ++kb) { const bf16x8 a = *(const bf16x8*)(ST + (size_t)u * 16384 + (td * 16 + cc) * 128 + kb * 32 + q * 8); acc[td] = mfma16(a, bq[kb], acc[td]); }
#pragma unroll
      for (int r = 0; r < 4; ++r) ss += acc[td][r] * acc[td][r];
    }
    ss += __shfl_xor(ss, 16); ss += __shfl_xor(ss, 32);
    const float rstd = rsqrtf(ss * (1.f / 128.f) + EPS);
#pragma unroll
    for (int td = 0; td < 8; ++td) {
      const f32x4 z = unpack4(*(const u32x2*)(P + t * LDP1 + 3072 + h * 128 + td * 16 + 4 * q));
      const f32x4 g = *(const f32x4*)(gn + td * 16 + 4 * q);
      f32x4 y;
#pragma unroll
      for (int r = 0; r < 4; ++r) y[r] = acc[td][r] * rstd * g[r] * siluf_(z[r]);
      *(u32x2*)(Y + t * D_ + h * 128 + td * 16 + 4 * q) = pack4(y);
    }
  }
}


__device__ __forceinline__ void ph_mix0_a(Frame& F, const Args& A) {
  const bf16_t* P = (const bf16_t*)(F.ws + WS_P); const float* SK = (const float*)(F.ws + WS_SK);
  const int tid = F.tid, lane = F.lane, wave = F.wave, q = lane >> 4, cc = lane & 15;
  LAS bf16_t* XC = (LAS bf16_t*)F.lds;
  LAS float* PB = (LAS float*)(F.lds + 140 * 1024);
  for (int i = tid; i < 512; i += NTHR) { PB[i] = A.in[10][i]; PB[512 + i] = A.in[12][i]; PB[1024 + i] = softplusf_(-A.in[13][i]); }
  const bf16_t* WAT = (const bf16_t*)(F.ws + WS_GW); const bf16_t* WXT = WAT + 8 * 4096;
  for (int u = F.bid; u < 256; u += F.G) {
    const int b = u >> 7, c = u & 127, t0 = u * 64;
    __syncthreads();
    {
      const int cg = tid & 63, tr = tid >> 6, ch0 = cg * 8;
      float w[4][8], bias[8];
#pragma unroll
      for (int j = 0; j < 4; ++j) { const f32x4 a = *(const f32x4*)(A.in[7] + j * 512 + ch0), bq = *(const f32x4*)(A.in[7] + j * 512 + ch0 + 4);
        w[j][0] = a[0]; w[j][1] = a[1]; w[j][2] = a[2]; w[j][3] = a[3]; w[j][4] = bq[0]; w[j][5] = bq[1]; w[j][6] = bq[2]; w[j][7] = bq[3]; }
      { const f32x4 a = *(const f32x4*)(A.in[8] + ch0), bq = *(const f32x4*)(A.in[8] + ch0 + 4); bias[0] = a[0]; bias[1] = a[1]; bias[2] = a[2]; bias[3] = a[3]; bias[4] = bq[0]; bias[5] = bq[1]; bias[6] = bq[2]; bias[7] = bq[3]; }
      float win[3][8];
#pragma unroll
      for (int j = 0; j < 3; ++j) {
        const int tl = c * 64 + tr * 8 - 3 + j;
        u32x4 v = {0u, 0u, 0u, 0u};
        if (tl >= 0) v = *(const u32x4*)(P + (size_t)(b * S_ + tl) * LDP0 + ch0);
        win[j][0] = bf2f(v.x & 0xffffu); win[j][1] = bf2f(v.x >> 16); win[j][2] = bf2f(v.y & 0xffffu); win[j][3] = bf2f(v.y >> 16);
        win[j][4] = bf2f(v.z & 0xffffu); win[j][5] = bf2f(v.z >> 16); win[j][6] = bf2f(v.w & 0xffffu); win[j][7] = bf2f(v.w >> 16);
      }
#pragma unroll
      for (int k = 0; k < 8; ++k) {
        const int tok = tr * 8 + k;
        const u32x4 v = *(const u32x4*)(P + (size_t)(t0 + tok) * LDP0 + ch0);
        float cur[8] = {bf2f(v.x & 0xffffu), bf2f(v.x >> 16), bf2f(v.y & 0xffffu), bf2f(v.y >> 16), bf2f(v.z & 0xffffu), bf2f(v.z >> 16), bf2f(v.w & 0xffffu), bf2f(v.w >> 16)};
        float o[8];
#pragma unroll
        for (int i = 0; i < 8; ++i) o[i] = bias[i] + w[0][i] * win[0][i] + w[1][i] * win[1][i] + w[2][i] * win[2][i] + w[3][i] * cur[i];
        u32x4 pk; pk.x = pk2(o[0], o[1]); pk.y = pk2(o[2], o[3]); pk.z = pk2(o[4], o[5]); pk.w = pk2(o[6], o[7]);
        *(LAS u32x4*)(XC + tok * 520 + ch0) = pk;
#pragma unroll
        for (int i = 0; i < 8; ++i) { win[0][i] = win[1][i]; win[1][i] = win[2][i]; win[2][i] = cur[i]; }
      }
    }
    __syncthreads();
    {
      const int h = wave;
      float* HL = (float*)(F.ws + WS_HLOC); float* CPp = (float*)(F.ws + WS_CP);
#pragma unroll 1
      for (int tj = 0; tj < 4; ++tj) {
        bf16x8 fa[2], fx[2];
#pragma unroll
        for (int kb = 0; kb < 2; ++kb) { fa[kb] = *(const bf16x8*)(WAT + h * 4096 + (tj * 16 + cc) * 64 + kb * 32 + q * 8); fx[kb] = *(const bf16x8*)(WXT + h * 4096 + (tj * 16 + cc) * 64 + kb * 32 + q * 8); }
        const int ch = h * 64 + tj * 16 + 4 * q;
        const f32x4 vba = *(const LAS f32x4*)(PB + ch), vbx = *(const LAS f32x4*)(PB + 512 + ch), vsp = *(const LAS f32x4*)(PB + 1024 + ch);
        f32x4 carH = {0.f, 0.f, 0.f, 0.f}, carP = {1.f, 1.f, 1.f, 1.f};
#pragma unroll 1
        for (int tt = 0; tt < 4; ++tt) {
          const int tok = tt * 16 + cc;
          f32x4 ar = {0.f, 0.f, 0.f, 0.f}, ai = {0.f, 0.f, 0.f, 0.f};
#pragma unroll
          for (int kb = 0; kb < 2; ++kb) { const bf16x8 bx_ = *(const LAS bf16x8*)(XC + tok * 520 + h * 64 + kb * 32 + q * 8); ar = mfma16(fa[kb], bx_, ar); ai = mfma16(fx[kb], bx_, ai); }
          const u32x2 xv = *(const LAS u32x2*)(XC + tok * 520 + ch); const f32x4 xcv = unpack4(xv);
          f32x4 Aa, Bb;
#pragma unroll
          for (int r = 0; r < 4; ++r) {
            const float rg = sigmoidf_(ar[r] + vba[r]), ig = sigmoidf_(ai[r] + vbx[r]);
            const float la = -8.f * rg * vsp[r];
            Aa[r] = __expf(la); Bb[r] = sqrtf(-expm1f(2.f * la)) * (ig * xcv[r]);
          }
#pragma unroll
          for (int d = 1; d < 16; d <<= 1) {
#pragma unroll
            for (int r = 0; r < 4; ++r) { const float pa = __shfl_up(Aa[r], d, 16), pb = __shfl_up(Bb[r], d, 16); if (cc >= d) { Bb[r] = Aa[r] * pb + Bb[r]; Aa[r] = Aa[r] * pa; } }
          }
          f32x4 hl, cp;
#pragma unroll
          for (int r = 0; r < 4; ++r) { hl[r] = Bb[r] + Aa[r] * carH[r]; cp[r] = Aa[r] * carP[r]; }
          *(f32x4*)(HL + (size_t)(t0 + tok) * 512 + ch) = hl; *(f32x4*)(CPp + (size_t)(t0 + tok) * 512 + ch) = cp;
#pragma unroll
          for (int r = 0; r < 4; ++r) { carH[r] = __shfl(hl[r], 15, 16); carP[r] = __shfl(cp[r], 15, 16); }
        }
      }
    }
    LAS float* GC = (LAS float*)F.lds;
    LAS float* SEG = (LAS float*)(F.lds + 16640);
    LAS bf16_t* QT = (LAS bf16_t*)(F.lds + 18688);
    LAS bf16_t* KH = (LAS bf16_t*)(F.lds + 27904);
    LAS bf16_t* KTT = (LAS bf16_t*)(F.lds + 37120);
    LAS bf16_t* VT = (LAS bf16_t*)(F.lds + 46336);
    LAS bf16_t* ATT = (LAS bf16_t*)(F.lds + 64768);
#pragma unroll 1
    for (int hh = 0; hh < 4; ++hh) {
      const int ug = (b * 4 + hh) * 128 + c;
      __syncthreads();
      {
        const int tok = tid >> 3, dk0 = (tid & 7) * 8;
        float gl[16];
#pragma unroll
        for (int i = 0; i < 4; ++i) { const f32x4 v = *(const f32x4*)(SK + (size_t)(t0 + tok) * 16 + 4 * i); gl[4*i] = v[0]; gl[4*i+1] = v[1]; gl[4*i+2] = v[2]; gl[4*i+3] = v[3]; }
        float v[8];
        { const f32x4 b0 = *(const f32x4*)(A.in[15] + hh * 64 + dk0), b1 = *(const f32x4*)(A.in[15] + hh * 64 + dk0 + 4); v[0] = b0[0]; v[1] = b0[1]; v[2] = b0[2]; v[3] = b0[3]; v[4] = b1[0]; v[5] = b1[1]; v[6] = b1[2]; v[7] = b1[3]; }
#pragma unroll
        for (int r = 0; r < 16; ++r) { const f32x4 w0 = *(const f32x4*)(A.in[14] + r * 256 + hh * 64 + dk0), w1 = *(const f32x4*)(A.in[14] + r * 256 + hh * 64 + dk0 + 4);
          v[0] += gl[r] * w0[0]; v[1] += gl[r] * w0[1]; v[2] += gl[r] * w0[2]; v[3] += gl[r] * w0[3]; v[4] += gl[r] * w1[0]; v[5] += gl[r] * w1[1]; v[6] += gl[r] * w1[2]; v[7] += gl[r] * w1[3]; }
#pragma unroll
        for (int i = 0; i < 8; ++i) GC[tok * 65 + dk0 + i] = (fminf(v[i], 0.f) - log1pf(__expf(-fabsf(v[i])))) * (1.f / 16.f);
      }
      __syncthreads();
      float loc[8];
      { const int dk = tid & 63, sg = tid >> 6; float a = 0.f;
#pragma unroll
        for (int i = 0; i < 8; ++i) { a += GC[(sg * 8 + i) * 65 + dk]; loc[i] = a; }
        SEG[sg * 64 + dk] = a; }
      __syncthreads();
      { const int dk = tid & 63, sg = tid >> 6; float off = 0.f;
        for (int s2 = 0; s2 < sg; ++s2) off += SEG[s2 * 64 + dk];
#pragma unroll
        for (int i = 0; i < 8; ++i) GC[(sg * 8 + i) * 65 + dk] = loc[i] + off; }
      __syncthreads();
      {
        const int tok = tid >> 3, part = tid & 7, dk0 = part * 8;
        const u32x4 qv = *(const u32x4*)(P + (size_t)(t0 + tok) * LDP0 + 1024 + hh * 64 + dk0), kv = *(const u32x4*)(P + (size_t)(t0 + tok) * LDP0 + 1280 + hh * 64 + dk0);
        const unsigned qq[4] = {qv.x, qv.y, qv.z, qv.w}, kk[4] = {kv.x, kv.y, kv.z, kv.w};
        float qt[8], kh[8];
#pragma unroll
        for (int i = 0; i < 8; ++i) {
          const float g = GC[tok * 65 + dk0 + i], gl_ = GC[63 * 65 + dk0 + i];
          const float qf = bf2f((i & 1) ? (qq[i >> 1] >> 16) : (qq[i >> 1] & 0xffffu)), kf = bf2f((i & 1) ? (kk[i >> 1] >> 16) : (kk[i >> 1] & 0xffffu));
          qt[i] = qf * __expf(g) * 0.125f; kh[i] = kf * __expf(-g);
          KTT[(dk0 + i) * 72 + tok] = (bf16_t)f2bf(kf * __expf(gl_ - g));
        }
        u32x4 o; o.x = pk2(qt[0], qt[1]); o.y = pk2(qt[2], qt[3]); o.z = pk2(qt[4], qt[5]); o.w = pk2(qt[6], qt[7]);
        *(LAS u32x4*)(QT + tok * 72 + dk0) = o; *(u32x4*)((bf16_t*)(F.ws + WS_QG) + (size_t)(t0 + tok) * 256 + hh * 64 + dk0) = o;
        o.x = pk2(kh[0], kh[1]); o.y = pk2(kh[2], kh[3]); o.z = pk2(kh[4], kh[5]); o.w = pk2(kh[6], kh[7]);
        *(LAS u32x4*)(KH + tok * 72 + dk0) = o;
        const bf16_t* vsrc = P + (size_t)(t0 + tok) * LDP0 + 1536 + hh * 128 + part * 16;
        const u32x4 v0 = *(const u32x4*)vsrc, v1 = *(const u32x4*)(vsrc + 8);
        const unsigned vv[8] = {v0.x, v0.y, v0.z, v0.w, v1.x, v1.y, v1.z, v1.w};
#pragma unroll
        for (int i = 0; i < 8; ++i) { VT[(part * 16 + 2 * i) * 72 + tok] = (bf16_t)(vv[i] & 0xffffu); VT[(part * 16 + 2 * i + 1) * 72 + tok] = (bf16_t)(vv[i] >> 16); }
        if (tid < 64) ((float*)(F.ws + WS_DEC))[(size_t)ug * 64 + tid] = __expf(GC[63 * 65 + tid]);
      }
      __syncthreads();
#pragma unroll 1
      for (int m = 0; m < 2; ++m) {
        const int id = wave * 2 + m, ti = id >> 2, tj = id & 3;
        f32x4 acc = {0.f, 0.f, 0.f, 0.f};
        if (tj <= ti) acc = mma_tile<64>(QT + ti * 16 * 72, 72, KH + tj * 16 * 72, 72, lane, acc);
#pragma unroll
        for (int r = 0; r < 4; ++r) { const int i = ti * 16 + 4 * q + r, j = tj * 16 + cc; ATT[i * 72 + j] = (bf16_t)f2bf(i >= j ? acc[r] : 0.f); }
      }
      __syncthreads();
#pragma unroll 1
      for (int m = 0; m < 8; ++m) {
        const int id = wave + 8 * m;
        f32x4 acc = {0.f, 0.f, 0.f, 0.f};
        if (id < 32) {
          const int tdv = id >> 2, tt = id & 3;
          acc = mma_tile<64>(VT + tdv * 16 * 72, 72, ATT + tt * 16 * 72, 72, lane, acc);
          *(u32x2*)((bf16_t*)(F.ws + WS_OLG) + (size_t)(t0 + tt * 16 + cc) * 512 + hh * 128 + tdv * 16 + 4 * q) = pack4(acc);
        } else {
          const int tdk = (id - 32) >> 3, tdv = id & 7;
          acc = mma_tile<64>(KTT + tdk * 16 * 72, 72, VT + tdv * 16 * 72, 72, lane, acc);
          *(f32x4*)((float*)(F.ws + WS_DST) + (size_t)ug * 8192 + (tdv * 16 + cc) * 64 + tdk * 16 + 4 * q) = acc;
        }
      }
    }
  }
}
__device__ __forceinline__ void ph_mix0_b(Frame& F) {
  if (F.bid < 128) {
    const int gidx = F.bid * NTHR + F.tid, bh = gidx >> 13, e = gidx & 8191, dk = e & 63;
    const float* DST = (const float*)(F.ws + WS_DST) + (size_t)bh * 128 * 8192 + e; bf16_t* STG = (bf16_t*)(F.ws + WS_STG) + (size_t)bh * 128 * 8192 + e;
    const float* DEC = (const float*)(F.ws + WS_DEC) + (size_t)bh * 128 * 64 + dk;
    float S = 0.f;
#pragma unroll 8
    for (int c = 0; c < 128; ++c) { const float d = DEC[c * 64], ds = DST[(size_t)c * 8192]; STG[(size_t)c * 8192] = (bf16_t)f2bf(S); S = d * S + ds; }
  } else if (F.bid < 130) {
    const int idx = (F.bid - 128) * NTHR + F.tid, b = idx >> 9, ch = idx & 511;
    const float* HL = (const float*)(F.ws + WS_HLOC); const float* CPp = (const float*)(F.ws + WS_CP); float* CAR = (float*)(F.ws + WS_CAR);
    float carry = 0.f;
#pragma unroll 8
    for (int c = 0; c < 128; ++c) { const size_t t = (size_t)b * S_ + c * 64 + 63; const float a = CPp[t * 512 + ch], hb = HL[t * 512 + ch]; CAR[(size_t)(b * 128 + c) * 512 + ch] = carry; carry = a * carry + hb; }
  }
}
__device__ __forceinline__ void ph_mix0_c(Frame& F, const Args& A) {
  const bf16_t* P = (const bf16_t*)(F.ws + WS_P); bf16_t* Y = (bf16_t*)(F.ws + WS_Y);
  const int tid = F.tid, lane = F.lane, wave = F.wave, q = lane >> 4, cc = lane & 15;
  for (int u = F.bid; u < 256; u += F.G) {
    const int b = u >> 7, c = u & 127, t0 = u * 64;
    {
      const int tok = tid >> 3, part = tid & 7; const size_t t = (size_t)t0 + tok;
      const float* HL = (const float*)(F.ws + WS_HLOC) + t * 512; const float* CPp = (const float*)(F.ws + WS_CP) + t * 512; const float* CAR = (const float*)(F.ws + WS_CAR) + (size_t)u * 512;
#pragma unroll 4
      for (int k = 0; k < 16; ++k) {
        const int ch = k * 32 + part * 4;
        const f32x4 hl = *(const f32x4*)(HL + ch), cp = *(const f32x4*)(CPp + ch), ca = *(const f32x4*)(CAR + ch);
        const f32x4 ga = unpack4(*(const u32x2*)(P + t * LDP0 + 512 + ch));
        f32x4 y;
#pragma unroll
        for (int r = 0; r < 4; ++r) y[r] = gelu_tanh(ga[r]) * (hl[r] + cp[r] * ca[r]);
        *(u32x2*)(Y + t * D_ + ch) = pack4(y);
      }
    }
    {
      const int hh = wave >> 1, ug = (b * 4 + hh) * 128 + c;
      const bf16_t* STG = (const bf16_t*)(F.ws + WS_STG) + (size_t)ug * 8192; const bf16_t* QG = (const bf16_t*)(F.ws + WS_QG); const bf16_t* OLG = (const bf16_t*)(F.ws + WS_OLG);
#pragma unroll 1
      for (int m = 0; m < 2; ++m) {
        const int tt = (wave & 1) * 2 + m; const size_t t = (size_t)t0 + tt * 16 + cc;
        bf16x8 bq[2];
#pragma unroll
        for (int kb = 0; kb < 2; ++kb) bq[kb] = *(const bf16x8*)(QG + t * 256 + hh * 64 + kb * 32 + q * 8);
        f32x4 acc[8]; float ss = 0.f;
#pragma unroll
        for (int td = 0; td < 8; ++td) {
          acc[td] = unpack4(*(const u32x2*)(OLG + t * 512 + hh * 128 + td * 16 + 4 * q));
#pragma unroll
          for (int kb = 0; kb < 2; ++kb) { const bf16x8 a = *(const bf16x8*)(STG + (td * 16 + cc) * 64 + kb * 32 + q * 8); acc[td] = mfma16(a, bq[kb], acc[td]); }
#pragma unroll
          for (int r = 0; r < 4; ++r) ss += acc[td][r] * acc[td][r];
        }
        ss += __shfl_xor(ss, 16); ss += __shfl_xor(ss, 32);
        const float rstd = rsqrtf(ss * (1.f / 128.f) + EPS);
#pragma unroll
        for (int td = 0; td < 8; ++td) {
          const f32x4 og = unpack4(*(const u32x2*)(P + t * LDP0 + 2048 + hh * 128 + td * 16 + 4 * q));
          const f32x4 g = *(const f32x4*)(A.in[16] + td * 16 + 4 * q);
          f32x4 y;
#pragma unroll
          for (int r = 0; r < 4; ++r) y[r] = acc[td][r] * rstd * g[r] * siluf_(og[r]);
          *(u32x2*)(Y + t * D_ + 512 + hh * 128 + td * 16 + 4 * q) = pack4(y);
        }
      }
    }
  }
}

enum { PH_PRO = 0, PH_N1_0, PH_GIN_0, PH_MIXA_0, PH_MIXB_0, PH_MIXC_0, PH_GOUT_0, PH_N2_0, PH_MOE1_0, PH_MOE2_0, PH_N1_1, PH_GIN_1, PH_MIXA_1, PH_MIXB_1, PH_MIXC_1, PH_GOUT_1, PH_N2_1, PH_MOE1_1, PH_MOE2_1, PH_FINAL, PH_COUNT };

#define PHASE(k) if (lo <= (k) && (k) < hi && ((k) == lo || (grid.sync(), true)))
template <int L>
__device__ __forceinline__ void layer_phases(Frame& F, const Args& args, cg::grid_group& grid, int lo, int hi, LAS int* tb, LAS int* cn) {
  constexpr int B = L * (PH_N1_1 - PH_N1_0);
  PHASE(B + PH_N1_0) { if (L == 0) ph_norm<0>(F, args, 0); else { convert_moe(F, args, 1); __syncthreads(); ph_norm<1>(F, args, 1); } }
  PHASE(B + PH_GIN_0) {
    pg8::StaticOrder S; S.init(T_, L == 0 ? LDP0 : LDP1, D_, F.G, F.bid);
    pg8::EpiBf16 E{(bf16_t*)(F.ws + WS_P), L == 0 ? LDP0 : LDP1};
    pg8::gemm_phase<pg8::EpiBf16, pg8::StaticOrder, true>(F.lds, (const bf16_t*)(F.ws + WS_XN), (const bf16_t*)(F.ws + (L == 0 ? WS_WIN0 : WS_WIN1)), D_, S, E);
  }
  if (L == 0) {
    PHASE(PH_MIXA_0) ph_mix0_a(F, args);
    PHASE(PH_MIXB_0) ph_mix0_b(F);
    PHASE(PH_MIXC_0) ph_mix0_c(F, args);
  }
  if (L == 1) {
    PHASE(PH_MIXA_1) ph_dn1(F, args);
    PHASE(PH_MIXB_1) ph_dn2(F);
    PHASE(PH_MIXC_1) ph_dn3(F, args);
  }
  PHASE(B + PH_GOUT_0) {
    pg8::StaticOrder S; S.init(T_, D_, D_, F.G, F.bid);
    pg8::EpiResGate E{L == 0 ? args.in[0] : F.out, F.out, (const float*)(F.ws + WS_MOD) + L * 2 * 6144 + 2 * 1024};
    pg8::gemm_phase<pg8::EpiResGate, pg8::StaticOrder, false>(F.lds, (const bf16_t*)(F.ws + WS_Y), (const bf16_t*)(F.ws + (L == 0 ? WS_WOUT0 : WS_WOUT1)), D_, S, E);
  }
  PHASE(B + PH_N2_0) ph_norm<2>(F, args, L);
  PHASE(B + PH_MOE1_0) {
    moe_tables(F, L, tb, cn);
    MoeSched<true> S{tb, cn, (const int*)(F.ws + WS_LIST), F.G, F.bid, D_, tb[32]};
    pg8::EpiSwiglu E{(bf16_t*)(F.ws + WS_HMID)};
    pg8::gemm_phase<pg8::EpiSwiglu, MoeSched<true>, true>(F.lds, (const bf16_t*)(F.ws + WS_XN), (const bf16_t*)(F.ws + WS_W13), D_, S, E);
  }
  PHASE(B + PH_MOE2_0) {
    moe_tables(F, L, tb, cn);
    MoeSched<false> S{tb, cn, (const int*)(F.ws + WS_LIST), F.G, F.bid, 512, tb[32]};
    pg8::EpiBf16 E{(bf16_t*)(F.ws + WS_YB), D_};
    pg8::gemm_phase<pg8::EpiBf16, MoeSched<false>, true>(F.lds, (const bf16_t*)(F.ws + WS_HMID), (const bf16_t*)(F.ws + WS_W2), 512, S, E);
  }
}
#undef PHASE

__global__ void __launch_bounds__(NTHR, 2) k_fwd(Args args) {
  extern __shared__ __attribute__((aligned(16))) unsigned char lds_raw[];
  cg::grid_group grid = cg::this_grid();
  Frame F;
  F.lds = (LAS unsigned char*)lds_raw;
  F.tid = threadIdx.x; F.lane = F.tid & 63; F.wave = __builtin_amdgcn_readfirstlane(F.tid >> 6);
  F.G = gridDim.x; F.bid = blockIdx.x;
  F.out = args.out; F.ws = args.ws;
  LAS int* tb = (LAS int*)(F.lds + 132 * 1024); LAS int* cn = tb + 40;
  const int lo = args.ph_lo, hi = args.ph_hi;
#define PHASE(k) if (lo <= (k) && (k) < hi && ((k) == lo || (grid.sync(), true)))
  PHASE(PH_PRO) { ph_prologue(F, args); convert_moe(F, args, 0); }
  layer_phases<0>(F, args, grid, lo, hi, tb, cn);
  layer_phases<1>(F, args, grid, lo, hi, tb, cn);
  PHASE(PH_FINAL) ph_norm<3>(F, args, 1);
}

__device__ __forceinline__ float ldb(const bf16_t* p, size_t i) { return bf2f(p[i]); }
__global__ __launch_bounds__(512) void k_rg_gates(const bf16_t* P, const float* conv_w, const float* conv_b, const float* wa, const float* ba, const float* wx, const float* bx, const float* lam, float* Aout, float* Bout) {
  __shared__ float xc[512];
  int t = blockIdx.x, ch = threadIdx.x, tl = t % S_;
  float v = conv_b[ch];
#pragma unroll
  for (int j = 0; j < 4; ++j) { int tt = tl - 3 + j; if (tt >= 0) v += conv_w[j * 512 + ch] * ldb(P, (size_t)(t - 3 + j) * LDP0 + ch); }
  xc[ch] = v;
  __syncthreads();
  int h = ch >> 6, jj = ch & 63;
  float r = ba[ch], ii = bx[ch];
  const float* wap = wa + h * 4096 + jj; const float* wxp = wx + h * 4096 + jj;
  for (int i = 0; i < 64; ++i) { float x = xc[h * 64 + i]; r += x * wap[i * 64]; ii += x * wxp[i * 64]; }
  r = sigmoidf_(r); ii = sigmoidf_(ii);
  float log_a = -8.f * r * softplusf_(-lam[ch]);
  float a = __expf(log_a);
  float bb = sqrtf(-expm1f(2.f * log_a)) * (ii * v);
  Aout[(size_t)t * 512 + ch] = a; Bout[(size_t)t * 512 + ch] = bb;
}
__global__ __launch_bounds__(64) void k_rg_scan(const float* Ain, const float* Bin, const bf16_t* P, bf16_t* Y) {
  int idx = blockIdx.x * 64 + threadIdx.x; int b = idx >> 9, ch = idx & 511;
  float h = 0.f;
  size_t t0 = (size_t)b * S_;
#pragma unroll 8
  for (int t = 0; t < S_; ++t) {
    float a = Ain[(t0 + t) * 512 + ch], bb = Bin[(t0 + t) * 512 + ch], ga = ldb(P, (t0 + t) * LDP0 + 512 + ch);
    h = a * h + bb;
    Y[(t0 + t) * D_ + ch] = (bf16_t)f2bf(gelu_tanh(ga) * h);
  }
}
__global__ __launch_bounds__(256) void k_gla_lg(const float* SK, const float* wg2, const float* bg2, float* LG) {
  int t = blockIdx.x, n = threadIdx.x;
  float v = bg2[n];
#pragma unroll
  for (int r = 0; r < 16; ++r) v += SK[(size_t)t * 16 + r] * wg2[r * 256 + n];
  float ls = fminf(v, 0.f) - log1pf(__expf(-fabsf(v)));
  LG[(size_t)t * 256 + n] = ls * (1.f / 16.f);
}
__global__ __launch_bounds__(128) void k_gla_rec(const bf16_t* P, const float* LG, float* O) {
  int b = blockIdx.x >> 2, h = blockIdx.x & 3, j = threadIdx.x;
  float s[64];
#pragma unroll
  for (int d = 0; d < 64; ++d) s[d] = 0.f;
  for (int t = 0; t < S_; ++t) {
    size_t row = (size_t)b * S_ + t;
    const bf16_t* q = P + row * LDP0 + 1024 + h * 64;
    const bf16_t* k = P + row * LDP0 + 1280 + h * 64;
    const float* lg = LG + row * 256 + h * 64;
    float v = ldb(P, row * LDP0 + 1536 + h * 128 + j);
    float o = 0.f;
#pragma unroll
    for (int d = 0; d < 64; ++d) { s[d] = __expf(lg[d]) * s[d] + bf2f(k[d]) * v; o += bf2f(q[d]) * s[d]; }
    O[row * 512 + h * 128 + j] = o * 0.125f;
  }
}
__global__ __launch_bounds__(256) void k_head_norm_gate(const float* O, int ldo, const float* g, const bf16_t* Pgate, int ldp, int gate_off, bf16_t* Y, int y_off, int nheads) {
  int w = blockIdx.x * 4 + (threadIdx.x >> 6), lane = threadIdx.x & 63;
  int t = w / nheads, h = w % nheads;
  float o0 = O[(size_t)t * ldo + h * 128 + lane], o1 = O[(size_t)t * ldo + h * 128 + 64 + lane];
  float ss = wave_sum(o0 * o0 + o1 * o1);
  float r = rsqrtf(ss * (1.f / 128.f) + EPS);
  float g0 = ldb(Pgate, (size_t)t * ldp + gate_off + h * 128 + lane), g1 = ldb(Pgate, (size_t)t * ldp + gate_off + h * 128 + 64 + lane);
  Y[(size_t)t * D_ + y_off + h * 128 + lane] = (bf16_t)f2bf(o0 * r * g[lane] * siluf_(g0));
  Y[(size_t)t * D_ + y_off + h * 128 + 64 + lane] = (bf16_t)f2bf(o1 * r * g[64 + lane] * siluf_(g1));
}
__global__ __launch_bounds__(256) void k_dn_prep(const bf16_t* P, const float* SK, const float* conv_w, const float* a_log, const float* dt_bias, float* QN, float* KN, float* V, float* BETA, float* G) {
  __shared__ float buf[3072];
  int t = blockIdx.x, tid = threadIdx.x, tl = t % S_;
  for (int c = tid; c < 3072; c += 256) {
    float v = 0.f;
#pragma unroll
    for (int j = 0; j < 4; ++j) { int tt = tl - 3 + j; if (tt >= 0) v += conv_w[j * 3072 + c] * ldb(P, (size_t)(t - 3 + j) * LDP1 + c); }
    buf[c] = siluf_(v);
  }
  __syncthreads();
  int w = tid >> 6, lane = tid & 63;
  for (int gi = w * 4; gi < w * 4 + 4; ++gi) {
    float x0 = buf[gi * 128 + lane], x1 = buf[gi * 128 + 64 + lane];
    float ss = wave_sum(x0 * x0 + x1 * x1);
    float sc = rsqrtf(ss + EPS);
    if (gi < 8) { sc *= 0.08838834764831845f; QN[(size_t)t * D_ + gi * 128 + lane] = x0 * sc; QN[(size_t)t * D_ + gi * 128 + 64 + lane] = x1 * sc; }
    else { int c = (gi - 8) * 128; KN[(size_t)t * D_ + c + lane] = x0 * sc; KN[(size_t)t * D_ + c + 64 + lane] = x1 * sc; }
  }
  for (int c = tid; c < 1024; c += 256) V[(size_t)t * D_ + c] = buf[2048 + c];
  if (tid < 8) {
    BETA[t * 8 + tid] = sigmoidf_(SK[(size_t)t * 16 + tid]);
    G[t * 8 + tid] = -__expf(a_log[tid]) * softplusf_(SK[(size_t)t * 16 + 8 + tid] + dt_bias[tid]);
  }
}
__global__ __launch_bounds__(128) void k_dn_rec(const float* QN, const float* KN, const float* V, const float* BETA, const float* G, float* O) {
  int b = blockIdx.x >> 3, h = blockIdx.x & 7, j = threadIdx.x;
  float s[128];
#pragma unroll
  for (int d = 0; d < 128; ++d) s[d] = 0.f;
  for (int t = 0; t < S_; ++t) {
    size_t row = (size_t)b * S_ + t;
    const float* q = QN + row * D_ + h * 128;
    const float* k = KN + row * D_ + h * 128;
    float v = V[row * D_ + h * 128 + j];
    float dec = __expf(G[row * 8 + h]), beta = BETA[row * 8 + h];
    float kd = 0.f;
#pragma unroll
    for (int d = 0; d < 128; ++d) { s[d] *= dec; kd += k[d] * s[d]; }
    float vn = beta * (v - kd);
    float o = 0.f;
#pragma unroll
    for (int d = 0; d < 128; ++d) { s[d] += k[d] * vn; o += q[d] * s[d]; }
    O[row * D_ + h * 128 + j] = o;
  }
}

extern "C" void kernel_launch(void* const* d_in, const int* in_sizes, int n_in, void* d_out, int out_size, void* d_ws, size_t ws_size, hipStream_t stream) {
  static int grid = 0;
  if (grid == 0) {
    if (n_in != 32 || ws_size < WS_END) { fprintf(stderr, "kernel_launch: bad inputs / workspace (%d inputs, ws %zu < %zu)\n", n_in, ws_size, (size_t)WS_END); grid = -1; return; }
    int dev = 0, cus = 0, per_cu = 0;
    hipGetDevice(&dev); hipDeviceGetAttribute(&cus, hipDeviceAttributeMultiprocessorCount, dev);
    if (hipFuncSetAttribute((const void*)k_fwd, hipFuncAttributeMaxDynamicSharedMemorySize, LDS_BYTES) != hipSuccess) { fprintf(stderr, "hipFuncSetAttribute failed\n"); grid = -1; return; }
    if (hipOccupancyMaxActiveBlocksPerMultiprocessor(&per_cu, (const void*)k_fwd, NTHR, LDS_BYTES) != hipSuccess || per_cu < 1) { fprintf(stderr, "occupancy query failed (%d)\n", per_cu); grid = -1; return; }
    grid = cus;
  }
  if (grid < 0) return;
  Args a{};
  for (int i = 0; i < 32; ++i) a.in[i] = (const float*)d_in[i];
  a.out = (float*)d_out; a.ws = (unsigned char*)d_ws;
  auto run = [&](int lo, int hi) {
    a.ph_lo = lo; a.ph_hi = hi; void* kargs[] = {&a};
    hipError_t e = hipLaunchCooperativeKernel((const void*)k_fwd, dim3(grid), dim3(NTHR), kargs, LDS_BYTES, stream);
    if (e != hipSuccess) fprintf(stderr, "cooperative launch failed: %s\n", hipGetErrorString(e));
  };
  unsigned char* ws = (unsigned char*)d_ws;
  const bf16_t* P = (const bf16_t*)(ws + WS_P); bf16_t* Y = (bf16_t*)(ws + WS_Y); const float* SK = (const float*)(ws + WS_SK);
  float* R0 = (float*)(ws + WS_SCR); float* R1 = R0 + (size_t)T_ * 1024; float* R3 = R1 + (size_t)T_ * 1024;
  float* R2 = (float*)(ws + WS_XN);
  const float* const* in = (const float* const*)d_in;
  run(PH_PRO, PH_COUNT);

}
```

```cpp
#include <hip/hip_runtime.h>
#include <hip/hip_cooperative_groups.h>
#include <cstdio>
#include <cstdint>
namespace cg = cooperative_groups;

#define LAS __attribute__((address_space(3)))
typedef unsigned short bf16_t;
typedef short bf16x8 __attribute__((ext_vector_type(8)));
typedef float f32x4 __attribute__((ext_vector_type(4)));
typedef unsigned u32x4 __attribute__((ext_vector_type(4)));
typedef unsigned u32x2 __attribute__((ext_vector_type(2)));

constexpr int T_ = 16384, D_ = 1024, S_ = 8192;
constexpr int PAB = 2576, PC = 4112;
constexpr int LDP0 = 2560, LDP1 = 4096;
constexpr float EPS = 1e-6f;
constexpr int NTHR = 512, NWAVE = 8;
constexpr int LDS_BYTES = 151552;
constexpr int MAXROWS = 40960;

__device__ __forceinline__ float sigmoidf_(float x) { return 1.f / (1.f + __expf(-x)); }
__device__ __forceinline__ float siluf_(float x) { return x / (1.f + __expf(-x)); }
__device__ __forceinline__ float softplusf_(float x) { return x > 20.f ? x : log1pf(__expf(x)); }
__device__ __forceinline__ float gelu_tanh(float x) { return 0.5f * x * (1.f + tanhf(0.7978845608028654f * (x + 0.044715f * x * x * x))); }
__device__ __forceinline__ float wave_sum(float v) {
#pragma unroll
  for (int o = 32; o > 0; o >>= 1) v += __shfl_xor(v, o);
  return v;
}
__device__ __forceinline__ unsigned f2bf(float f) { unsigned u = __float_as_uint(f); return (u + 0x7fffu + ((u >> 16) & 1u)) >> 16; }
__device__ __forceinline__ float bf2f(unsigned h) { return __uint_as_float(h << 16); }
__device__ __forceinline__ unsigned pk2(float lo, float hi) { return f2bf(lo) | (f2bf(hi) << 16); }

namespace pg8 {
constexpr int BM = 256, BK = 64, HALF = 128, HTB = HALF * BK * 2, STAGE_BYTES = 8 * HTB, NXCD = 8, WGM = 8;
__device__ __forceinline__ int lds_byte(int r, int c) { const int st = (r >> 4) * 2 + (c >> 5), rr = r & 15, cc = c & 31, ob = rr * 64 + cc * 2; return st * 1024 + (ob ^ (((ob >> 9) & 1) << 5)); }
__device__ __forceinline__ void stage_rc(int b, int& R, int& C) { const int st = b / 1024, sb = b % 1024, swz = sb ^ (((sb >> 9) & 1) << 5); R = (st >> 1) * 16 + swz / 64; C = (st & 1) * 32 + (swz % 64) / 2; }
__device__ __forceinline__ int perm32(int rho) { const int n = rho >> 4, i = rho & 15; return 8 * (i >> 2) + 4 * n + (i & 3); }

struct Unit { int pm, pn, pc, e, slot0, cnt; };

struct StaticOrder {
  static constexpr bool GATHER = false;
  int nM, nN, nwg, G, c, K;
  __device__ void init(int M, int N, int K_, int G_, int c_) { nM = M / BM; nN = N / BM; nwg = nM * nN; G = G_; c = c_; K = K_; }
  __device__ bool next(int i, Unit& u) const {
    const long L = (long)i * G + c; if (L >= nwg) return false;
    int wgid = (int)L; { const int q = nwg / NXCD, r = nwg % NXCD, xcd = wgid % NXCD, off = wgid / NXCD; wgid = (xcd < r ? xcd * (q + 1) : r * (q + 1) + (xcd - r) * q) + off; }
    const int nig = WGM * nN, gid = wgid / nig, fm = gid * WGM, gsz = (nM - fm) < WGM ? (nM - fm) : WGM;
    u.pm = fm + ((wgid % nig) % gsz); u.pn = (wgid % nig) / gsz; u.pc = u.pn; u.e = 0; u.slot0 = 0; u.cnt = 0; return true;
  }
  __device__ __forceinline__ unsigned aoff(const Unit& u, int row, int col) const { return (unsigned)(((u.pm * BM + row) * K + col) * 2); }
};

__device__ __forceinline__ unsigned cvt_pk_bf16(float lo, float hi) { unsigned r; asm volatile("v_cvt_pk_bf16_f32 %0, %1, %2" : "=v"(r) : "v"(lo), "v"(hi)); return r; }

struct EpiBf16 {
  static constexpr bool PERM = true;
  bf16_t* O; int ldc;
  __device__ __forceinline__ void operator()(const f32x4 (&acc)[2][2][4][2], const Unit& u, int wr, int wc, int fr, int fq) const {
    const int row0 = u.pm * BM + wr * 64 + fr, col0 = u.pc * BM + wc * 32 + 8 * fq;
#pragma unroll
    for (int ai = 0; ai < 2; ++ai)
#pragma unroll
      for (int m = 0; m < 4; ++m) { bf16_t* rowp = O + (size_t)(row0 + ai * HALF + m * 16) * ldc + col0;
#pragma unroll
        for (int bj = 0; bj < 2; ++bj) { const f32x4 v0 = acc[ai][bj][m][0], v1 = acc[ai][bj][m][1];
          u32x4 w; w.x = cvt_pk_bf16(v0[0], v0[1]); w.y = cvt_pk_bf16(v0[2], v0[3]); w.z = cvt_pk_bf16(v1[0], v1[1]); w.w = cvt_pk_bf16(v1[2], v1[3]);
          *(u32x4*)(rowp + bj * HALF) = w; } }
  }
};
struct EpiResGate {
  static constexpr bool PERM = false;
  const float* res; float* out; const float* gate;
  __device__ __forceinline__ void operator()(const f32x4 (&acc)[2][2][4][2], const Unit& u, int wr, int wc, int fr, int fq) const {
#pragma unroll
    for (int ai = 0; ai < 2; ++ai)
#pragma unroll
      for (int m = 0; m < 4; ++m) { const int row = u.pm * BM + ai * HALF + wr * 64 + m * 16 + fr; const int b = row / S_;
#pragma unroll
        for (int bj = 0; bj < 2; ++bj)
#pragma unroll
          for (int n = 0; n < 2; ++n) { const int col = u.pc * BM + bj * HALF + wc * 32 + n * 16 + 4 * fq;
            const f32x4 g = *(const f32x4*)(gate + b * 6144 + col); const f32x4 r = *(const f32x4*)(res + (size_t)row * D_ + col);
            *(f32x4*)(out + (size_t)row * D_ + col) = r + g * acc[ai][bj][m][n]; } }
  }
};
struct EpiSwiglu {
  static constexpr bool PERM = true;
  bf16_t* O;
  __device__ __forceinline__ void operator()(const f32x4 (&acc)[2][2][4][2], const Unit& u, int wr, int wc, int fr, int fq) const {
    const int row0 = u.pm * BM + wr * 64 + fr, col0 = u.pc * HALF + wc * 32 + 8 * fq;
#pragma unroll
    for (int ai = 0; ai < 2; ++ai)
#pragma unroll
      for (int m = 0; m < 4; ++m) { bf16_t* rowp = O + (size_t)(row0 + ai * HALF + m * 16) * 512 + col0;
        float v[8];
#pragma unroll
        for (int n = 0; n < 2; ++n)
#pragma unroll
          for (int i = 0; i < 4; ++i) { const float g = acc[ai][0][m][n][i], up = acc[ai][1][m][n][i]; v[n * 4 + i] = g / (1.f + __expf(-g)) * up; }
        u32x4 w; w.x = cvt_pk_bf16(v[0], v[1]); w.y = cvt_pk_bf16(v[2], v[3]); w.z = cvt_pk_bf16(v[4], v[5]); w.w = cvt_pk_bf16(v[6], v[7]);
        *(u32x4*)rowp = w; }
  }
};

template <class Epi, class Sched, bool ALIGN_EPI>
__device__ __forceinline__ void gemm_phase(LAS unsigned char* lds, const bf16_t* A, const bf16_t* Bt, int K, const Sched& S, const Epi& E) {
  const int tid = threadIdx.x, wid = __builtin_amdgcn_readfirstlane(tid >> 6), lane = tid & 63, wr = wid >> 2, wc = wid & 3, fr = lane & 15, fq = lane >> 4;
  const int nt = K / BK;
  int Rr[2], Cc[2]; unsigned voffB[2];
#pragma unroll
  for (int i = 0; i < 2; ++i) { int R, C; stage_rc(tid * 16 + i * 8192, R, C); Rr[i] = R; Cc[i] = C; const int Rb = Epi::PERM ? ((R & ~31) + perm32(R & 31)) : R; voffB[i] = (unsigned)(Rb * K + C) * 2u; }
  const size_t kstep = (size_t)(BK * 2), hstep = (size_t)HALF * K * 2, tstep = 2 * hstep;
  const unsigned ldsw = (unsigned)wid * 1024u;
  const int aoff = lds_byte(wr * 64 + fr, fq * 8), boff = lds_byte(wc * 32 + fr, fq * 8);
#define PG8_SA(b, h) (((b) * 2 + (h)) * HTB)
#define PG8_SB(b, h) ((4 + (b) * 2 + (h)) * HTB)
#define PG8_STAGE(bufoff, gbase, voff) do { _Pragma("unroll") for (int _i = 0; _i < 2; ++_i) \
    __builtin_amdgcn_global_load_lds((const unsigned*)((const char*)(gbase) + (voff)[_i]), (LAS unsigned*)(lds + (bufoff) + ldsw + _i * 8192), 16, 0, 0); } while (0)
#define PG8_LDA(dst, b, h) do { _Pragma("unroll") for (int m = 0; m < 4; ++m) _Pragma("unroll") for (int k = 0; k < 2; ++k) dst[m][k] = *(const LAS bf16x8*)(lds + PG8_SA(b, h) + aoff + m * 2048 + k * 1024); } while (0)
#define PG8_LDB(dst, b, h) do { _Pragma("unroll") for (int n = 0; n < 2; ++n) _Pragma("unroll") for (int k = 0; k < 2; ++k) dst[n][k] = *(const LAS bf16x8*)(lds + PG8_SB(b, h) + boff + n * 2048 + k * 1024); } while (0)
#define PG8_MMA(ai, bj, At, Bt_) do { __builtin_amdgcn_s_setprio(1); _Pragma("unroll") for (int m = 0; m < 4; ++m) _Pragma("unroll") for (int n = 0; n < 2; ++n) _Pragma("unroll") for (int k = 0; k < 2; ++k) \
    acc[ai][bj][m][n] = __builtin_amdgcn_mfma_f32_16x16x32_bf16(Bt_[n][k], At[m][k], acc[ai][bj][m][n], 0, 0, 0); __builtin_amdgcn_s_setprio(0); } while (0)
#define PG8_WAIT_V(n) asm volatile("s_waitcnt vmcnt(" #n ")" ::: "memory")
#define PG8_WAIT_L(n) asm volatile("s_waitcnt lgkmcnt(" #n ")" ::: "memory")
#define PG8_BAR __builtin_amdgcn_s_barrier()
#define PG8_SCHED __builtin_amdgcn_sched_barrier(0)
  Unit cur, nxt; int ui = 0;
  if (!S.next(0, cur)) return;
  f32x4 acc[2][2][4][2];
#pragma unroll
  for (int a = 0; a < 2; ++a)
#pragma unroll
    for (int b = 0; b < 2; ++b)
#pragma unroll
      for (int m = 0; m < 4; ++m)
#pragma unroll
        for (int n = 0; n < 2; ++n) acc[a][b][m][n] = (f32x4){0.f, 0.f, 0.f, 0.f};
  bf16x8 At[4][2], B0[2][2], B1[2][2];
  constexpr bool GATHER = Sched::GATHER;
  unsigned cA0[2], cA1[2], nA0[2], nA1[2];
  const char* Ab = (const char*)A;
  const char* nAb = Ab;
  if constexpr (GATHER) {
#pragma unroll
    for (int i = 0; i < 2; ++i) { cA0[i] = S.aoff(cur, Rr[i], Cc[i]); cA1[i] = S.aoff(cur, HALF + Rr[i], Cc[i]); }
  } else {
#pragma unroll
    for (int i = 0; i < 2; ++i) { cA0[i] = (unsigned)(Rr[i] * K + Cc[i]) * 2u; cA1[i] = cA0[i] + (unsigned)hstep; }
    Ab = (const char*)A + (size_t)cur.pm * tstep;
  }
  const char* cB = (const char*)Bt + (size_t)cur.pn * tstep;
  PG8_STAGE(PG8_SB(0, 0), cB, voffB); PG8_STAGE(PG8_SB(0, 1), cB + hstep, voffB); PG8_STAGE(PG8_SA(0, 0), Ab, cA0); PG8_STAGE(PG8_SA(0, 1), Ab, cA1);
  if (wr == 1) PG8_BAR;
  PG8_WAIT_V(2); PG8_BAR;
  PG8_STAGE(PG8_SB(1, 0), cB + kstep, voffB); PG8_STAGE(PG8_SA(1, 0), Ab + kstep, cA0); PG8_STAGE(PG8_SB(1, 1), cB + hstep + kstep, voffB);
  PG8_WAIT_V(6); PG8_BAR;
  for (;;) {
    const bool has_next = S.next(ui + 1, nxt);
    if constexpr (GATHER) {
#pragma unroll
      for (int i = 0; i < 2; ++i) { nA0[i] = has_next ? S.aoff(nxt, Rr[i], Cc[i]) : cA0[i]; nA1[i] = has_next ? S.aoff(nxt, HALF + Rr[i], Cc[i]) : cA1[i]; }
    } else { nAb = has_next ? (const char*)A + (size_t)nxt.pm * tstep : Ab; }
    const char* nB = has_next ? (const char*)Bt + (size_t)nxt.pn * tstep : cB;
    for (int t = 0; t < nt; t += 2) {
      const bool last = (t == nt - 2);
      const char* a1 = Ab + (size_t)(t + 1) * kstep;
      const char* a2 = last ? nAb : Ab + (size_t)(t + 2) * kstep; const char* b2 = last ? nB : cB + (size_t)(t + 2) * kstep;
      const char* a3 = a2 + kstep; const char* b3 = b2 + kstep;
      PG8_LDB(B0, 0, 0); PG8_LDB(B1, 0, 1); PG8_SCHED; PG8_LDA(At, 0, 0); PG8_STAGE(PG8_SA(1, 1), a1, cA1);
      if constexpr (GATHER) { if (last) {
#pragma unroll
        for (int i = 0; i < 2; ++i) { cA0[i] = nA0[i]; cA1[i] = nA1[i]; } } }
      PG8_WAIT_V(8); PG8_WAIT_L(0); PG8_BAR; PG8_MMA(0, 0, At, B0); PG8_MMA(0, 1, At, B1); PG8_BAR; PG8_SCHED;
      PG8_LDA(At, 0, 1); PG8_STAGE(PG8_SB(0, 0), b2, voffB); PG8_STAGE(PG8_SB(0, 1), b2 + hstep, voffB); PG8_STAGE(PG8_SA(0, 0), a2, cA0);
      PG8_WAIT_V(8); PG8_WAIT_L(0); PG8_BAR; PG8_MMA(1, 0, At, B0); PG8_MMA(1, 1, At, B1); PG8_BAR; PG8_SCHED;
      PG8_LDB(B0, 1, 0); PG8_LDB(B1, 1, 1); PG8_SCHED; PG8_LDA(At, 1, 0); PG8_STAGE(PG8_SA(0, 1), a2, cA1);
      PG8_WAIT_V(8); PG8_WAIT_L(0); PG8_BAR; PG8_MMA(0, 0, At, B0); PG8_MMA(0, 1, At, B1); PG8_BAR; PG8_SCHED;
      PG8_LDA(At, 1, 1); PG8_STAGE(PG8_SB(1, 0), b3, voffB); PG8_STAGE(PG8_SB(1, 1), b3 + hstep, voffB); PG8_STAGE(PG8_SA(1, 0), a3, cA0);
      PG8_WAIT_V(8); PG8_WAIT_L(0); PG8_BAR; PG8_MMA(1, 0, At, B0); PG8_MMA(1, 1, At, B1); PG8_BAR; PG8_SCHED;
    }
    if constexpr (ALIGN_EPI) { if (wr == 0) PG8_BAR; }
    E(acc, cur, wr, wc, fr, fq);
    if (!has_next) break;
#pragma unroll
    for (int a = 0; a < 2; ++a)
#pragma unroll
      for (int b = 0; b < 2; ++b)
#pragma unroll
        for (int m = 0; m < 4; ++m)
#pragma unroll
          for (int n = 0; n < 2; ++n) acc[a][b][m][n] = (f32x4){0.f, 0.f, 0.f, 0.f};
    cur = nxt; cB = nB; ++ui;
    if constexpr (!GATHER) Ab = nAb;
    if constexpr (ALIGN_EPI) { if (wr == 1) PG8_BAR; }
  }
  PG8_WAIT_V(0);
  if constexpr (!ALIGN_EPI) { if (wr == 0) PG8_BAR; }
  PG8_BAR;
#undef PG8_SA
#undef PG8_SB
#undef PG8_STAGE
#undef PG8_LDA
#undef PG8_LDB
#undef PG8_MMA
#undef PG8_WAIT_V
#undef PG8_WAIT_L
#undef PG8_BAR
#undef PG8_SCHED
}
}

struct Args {
  const float* in[32];
  float* out;
  unsigned char* ws;
  int ph_lo, ph_hi;
};
constexpr size_t MiB = 1u << 20;
constexpr size_t WS_CTL = 0;
constexpr size_t WS_MOD = 64 * 1024;
constexpr size_t WS_TOK = 1 * MiB;
constexpr size_t WS_LIST = 2 * MiB;
constexpr size_t WS_SK = 4 * MiB;
constexpr size_t WS_WIN0 = 6 * MiB;
constexpr size_t WS_WOUT0 = 11 * MiB;
constexpr size_t WS_WIN1 = 13 * MiB;
constexpr size_t WS_WOUT1 = 21 * MiB;
constexpr size_t WS_W13 = 24 * MiB;
constexpr size_t WS_W2 = 88 * MiB;
constexpr size_t WS_XN = 120 * MiB;
constexpr size_t WS_Y = 152 * MiB;
constexpr size_t WS_P = 184 * MiB;
constexpr size_t WS_HMID = WS_P;
constexpr size_t WS_YB = WS_P + 40 * MiB;
constexpr size_t WS_SCR = 312 * MiB;
constexpr size_t WS_END = 504 * MiB;
constexpr size_t WS_GW = 512 * 1024;
constexpr size_t WS_HLOC = WS_SCR;
constexpr size_t WS_CP = WS_SCR + 32 * MiB;
constexpr size_t WS_DST = WS_SCR + 64 * MiB;
constexpr size_t WS_STG = WS_SCR + 96 * MiB;
constexpr size_t WS_OLG = WS_SCR + 112 * MiB;
constexpr size_t WS_QG = WS_SCR + 128 * MiB;
constexpr size_t WS_DEC = WS_SCR + 136 * MiB;
constexpr size_t WS_CAR = WS_SCR + 137 * MiB;
constexpr size_t WS_AC = WS_SCR;
constexpr size_t WS_BCT = WS_SCR + 64 * MiB;
constexpr size_t WS_QH = WS_SCR + 128 * MiB;
constexpr size_t WS_OLOC = WS_SCR + 160 * MiB;

struct Frame {
  LAS unsigned char* lds;
  int tid, lane, wave, G, bid;
  float* out; unsigned char* ws;
};

__device__ __forceinline__ void transpose_item(const float* W, int ldw, int K, bf16_t* WT, int k0, int n0, int row0, LAS float* scr, int lane) {
#pragma unroll 8
  for (int i = 0; i < 32; ++i) { const int kk = 2 * i + (lane >> 5); scr[kk * 33 + (lane & 31)] = W[(size_t)(k0 + kk) * ldw + n0 + (lane & 31)]; }
  asm volatile("s_waitcnt lgkmcnt(0)" ::: "memory");
  const int c = lane & 7;
#pragma unroll
  for (int j = 0; j < 4; ++j) { const int n = (lane >> 3) + 8 * j; const LAS float* s = scr + (8 * c) * 33 + n;
    u32x4 o; o.x = pk2(s[0 * 33], s[1 * 33]); o.y = pk2(s[2 * 33], s[3 * 33]); o.z = pk2(s[4 * 33], s[5 * 33]); o.w = pk2(s[6 * 33], s[7 * 33]);
    *(u32x4*)(WT + (size_t)(row0 + n) * K + k0 + 8 * c) = o; }
  asm volatile("s_waitcnt lgkmcnt(0)" ::: "memory");
}
__device__ __forceinline__ void convert_moe(Frame& F, const Args& A, int layer) {
  LAS float* scr = (LAS float*)(F.lds + F.wave * 16384);
  const int gw = F.bid * NWAVE + F.wave, NGW = F.G * NWAVE;
  for (int it = gw; it < 32 * 768; it += NGW) {
    const int e = it / 768; int r = it % 768; const int le = layer * 32 + e;
    if (r < 512) {
      const int which = r >> 8, rr = r & 255, kb = rr / 16, nb = rr % 16, n0 = nb * 32;
      const float* W = (which ? A.in[29] : A.in[28]) + (size_t)le * 1024 * 512;
      transpose_item(W, 512, 1024, (bf16_t*)(F.ws + WS_W13) + (size_t)e * 1024 * 1024, kb * 64, n0, (n0 >> 7) * 256 + (n0 & 127) + which * 128, scr, F.lane);
    } else {
      const int rr = r - 512, kb = rr / 32, nb = rr % 32;
      transpose_item(A.in[30] + (size_t)le * 512 * 1024, 1024, 512, (bf16_t*)(F.ws + WS_W2) + (size_t)e * 1024 * 512, kb * 64, nb * 32, nb * 32, scr, F.lane);
    }
  }
}
__device__ __forceinline__ void ph_prologue(Frame& F, const Args& A) {
  LAS float* scr = (LAS float*)(F.lds + F.wave * 16384);
  const int gw = F.bid * NWAVE + F.wave, NGW = F.G * NWAVE;
  if (F.bid == 0 && F.tid < 64) ((int*)(F.ws + WS_CTL))[F.tid] = 0;
  constexpr int I_IN0 = 16 * 80, I_OUT = 16 * 32, I_IN1 = 16 * 128;
  constexpr int NIT = I_IN0 + I_OUT + I_IN1 + I_OUT;
  for (int it = gw; it < NIT; it += NGW) {
    int r = it;
    if (r < I_IN0) { const int kb = r / 80, nb = r % 80; transpose_item(A.in[6], PAB, 1024, (bf16_t*)(F.ws + WS_WIN0), kb * 64, nb * 32, nb * 32, scr, F.lane); continue; } r -= I_IN0;
    if (r < I_OUT) { const int kb = r / 32, nb = r % 32; transpose_item(A.in[17], 1024, 1024, (bf16_t*)(F.ws + WS_WOUT0), kb * 64, nb * 32, nb * 32, scr, F.lane); continue; } r -= I_OUT;
    if (r < I_IN1) { const int kb = r / 128, nb = r % 128; transpose_item(A.in[18], PC, 1024, (bf16_t*)(F.ws + WS_WIN1), kb * 64, nb * 32, nb * 32, scr, F.lane); continue; } r -= I_IN1;
    { const int kb = r / 32, nb = r % 32; transpose_item(A.in[23], 1024, 1024, (bf16_t*)(F.ws + WS_WOUT1), kb * 64, nb * 32, nb * 32, scr, F.lane); }
  }
  {
    bf16_t* WAT = (bf16_t*)(F.ws + WS_GW);
    for (int idx = F.bid * NTHR + F.tid; idx < 65536; idx += F.G * NTHR) { const int mtx = idx >> 15, h = (idx >> 12) & 7, j = (idx >> 6) & 63, i = idx & 63;
      WAT[idx] = (bf16_t)f2bf((mtx ? A.in[11] : A.in[9])[h * 4096 + i * 64 + j]); }
  }
  const float* c = A.in[1]; const float* w_ada = A.in[4]; const float* b_ada = A.in[5]; float* mod = (float*)(F.ws + WS_MOD);
  for (int un = gw; un < 384; un += NGW) {
    const int l = un / 192, n0 = (un % 192) * 32, kg = F.lane >> 3, cq = F.lane & 7;
    f32x4 a0 = {0.f, 0.f, 0.f, 0.f}, a1 = {0.f, 0.f, 0.f, 0.f};
    const float* w = w_ada + (size_t)l * 1024 * 6144 + n0 + cq * 4;
#pragma unroll 4
    for (int k = kg * 128; k < kg * 128 + 128; ++k) { const f32x4 wv = *(const f32x4*)(w + (size_t)k * 6144); const float c0 = siluf_(c[k]), c1 = siluf_(c[1024 + k]); a0 += wv * c0; a1 += wv * c1; }
#pragma unroll
    for (int o = 8; o < 64; o <<= 1)
#pragma unroll
      for (int i = 0; i < 4; ++i) { a0[i] += __shfl_xor(a0[i], o); a1[i] += __shfl_xor(a1[i], o); }
    if (kg == 0) { const f32x4 bb = *(const f32x4*)(b_ada + l * 6144 + n0 + cq * 4);
      *(f32x4*)(mod + (l * 2 + 0) * 6144 + n0 + cq * 4) = a0 + bb; *(f32x4*)(mod + (l * 2 + 1) * 6144 + n0 + cq * 4) = a1 + bb; }
  }
}

template <int MODE>
__device__ __forceinline__ void ph_norm(Frame& F, const Args& A, int l) {
  constexpr bool COMBINE = (MODE == 1 || MODE == 3);
  constexpr int NS = (MODE == 2) ? 36 : (MODE == 3 ? 0 : 16);
  constexpr int NSP = (MODE == 2) ? 36 : 20;
  LAS float* wl = (LAS float*)F.lds;
  LAS int* tb = (LAS int*)(F.lds + 147456);
  LAS int* lcnt = (LAS int*)(F.lds + 147456 + 256);
  LAS int* rinfo = (LAS int*)(F.lds + 147456 + 1024);
  if (MODE == 2 && F.tid < 64) lcnt[F.tid] = 0;
  const float* mod = (const float*)(F.ws + WS_MOD);
  if (NS > 0) {
#pragma unroll 1
    for (int k = F.tid; k < 1024; k += NTHR) {
      const int rho = ((k >> 2) & 63) + 64 * (((k >> 8) << 2) + (k & 3));
      LAS float* dst = wl + rho * NSP;
      if (MODE == 2) {
        *(LAS f32x4*)dst = *(const f32x4*)(A.in[24] + (size_t)l * 4096 + k * 4);
        const float* src = A.in[26] + (size_t)l * 32768 + k * 32;
#pragma unroll
        for (int i = 0; i < 8; ++i) *(LAS f32x4*)(dst + 4 + 4 * i) = *(const f32x4*)(src + 4 * i);
      } else {
        const float* src = MODE == 0 ? A.in[6] + (size_t)k * PAB + 2560 : A.in[18] + (size_t)k * PC + 4096;
#pragma unroll
        for (int i = 0; i < 4; ++i) *(LAS f32x4*)(dst + 4 * i) = *(const f32x4*)(src + 4 * i);
      }
    }
  }
  const int lc = (MODE == 1) ? 0 : 1;
  if (COMBINE) { if (F.tid == 0) { const int* cnt = (const int*)(F.ws + WS_CTL) + lc * 32; int acc = 0;
#pragma unroll 1
    for (int e = 0; e < 32; ++e) { tb[e] = acc; acc += (cnt[e] + 255) >> 8; } } }
  __syncthreads();
  const float* hin = (MODE == 0) ? A.in[0] : F.out;
  const float* gvec = (MODE == 3) ? A.in[31] : (MODE == 2 ? A.in[3] + l * D_ : A.in[2] + l * D_);
  const float* modl = mod + l * 2 * 6144;
  const int shp = (MODE == 2) ? 3 : 0, scp = (MODE == 2) ? 4 : 1;
  const int* tok_e = (const int*)(F.ws + WS_TOK); const int* tok_s = tok_e + 2 * T_; const float* tok_w = (const float*)(tok_s + 2 * T_);
  const bf16_t* yb = (const bf16_t*)(F.ws + WS_YB);
  bf16_t* xn = (bf16_t*)(F.ws + WS_XN);
  const int gw = F.bid * NWAVE + F.wave, NGW = F.G * NWAVE, lane = F.lane;
  constexpr int RPW = 2;
  for (int it = gw; it < T_ / RPW; it += NGW) {
    float u[RPW][16];
#pragma unroll
    for (int r = 0; r < RPW; ++r) {
      const int row = it * RPW + r, b = row / S_;
      const float* hr = hin + (size_t)row * D_;
      float v[16];
#pragma unroll
      for (int j = 0; j < 4; ++j) { const f32x4 x = *(const f32x4*)(hr + lane * 4 + 256 * j); v[4*j] = x[0]; v[4*j+1] = x[1]; v[4*j+2] = x[2]; v[4*j+3] = x[3]; }
      if (COMBINE) {
        const int e0 = tok_e[row * 2], e1 = tok_e[row * 2 + 1];
        const int r0 = tb[e0] * 256 + tok_s[row * 2], r1 = tb[e1] * 256 + tok_s[row * 2 + 1];
        const float w0 = tok_w[row * 2], w1 = tok_w[row * 2 + 1];
        const float* g2 = mod + (lc * 2 + b) * 6144 + 5 * 1024;
#pragma unroll
        for (int j = 0; j < 4; ++j) {
          const u32x2 y0 = *(const u32x2*)(yb + (size_t)r0 * D_ + lane * 4 + 256 * j), y1 = *(const u32x2*)(yb + (size_t)r1 * D_ + lane * 4 + 256 * j);
          const f32x4 g = *(const f32x4*)(g2 + lane * 4 + 256 * j);
          v[4*j]   += g[0] * (w0 * bf2f(y0.x & 0xffffu) + w1 * bf2f(y1.x & 0xffffu));
          v[4*j+1] += g[1] * (w0 * bf2f(y0.x >> 16) + w1 * bf2f(y1.x >> 16));
          v[4*j+2] += g[2] * (w0 * bf2f(y0.y & 0xffffu) + w1 * bf2f(y1.y & 0xffffu));
          v[4*j+3] += g[3] * (w0 * bf2f(y0.y >> 16) + w1 * bf2f(y1.y >> 16));
        }
        if (MODE == 1) {
#pragma unroll
          for (int j = 0; j < 4; ++j) *(f32x4*)(F.out + (size_t)row * D_ + lane * 4 + 256 * j) = (f32x4){v[4*j], v[4*j+1], v[4*j+2], v[4*j+3]};
        }
      }
      float ss = 0.f;
#pragma unroll
      for (int i = 0; i < 16; ++i) ss += v[i] * v[i];
      ss = wave_sum(ss);
      const float rstd = rsqrtf(ss * (1.f / D_) + EPS);
#pragma unroll
      for (int j = 0; j < 4; ++j) {
        const f32x4 g = *(const f32x4*)(gvec + lane * 4 + 256 * j);
        f32x4 y = {v[4*j] * rstd * g[0], v[4*j+1] * rstd * g[1], v[4*j+2] * rstd * g[2], v[4*j+3] * rstd * g[3]};
        if (MODE != 3) { const f32x4 sc = *(const f32x4*)(modl + b * 6144 + scp * 1024 + lane * 4 + 256 * j), sh = *(const f32x4*)(modl + b * 6144 + shp * 1024 + lane * 4 + 256 * j); y = y * (1.f + sc) + sh; }
        u[r][4*j] = y[0]; u[r][4*j+1] = y[1]; u[r][4*j+2] = y[2]; u[r][4*j+3] = y[3];
        if (MODE == 3) *(f32x4*)(F.out + (size_t)row * D_ + lane * 4 + 256 * j) = y;
        else { u32x2 p; p.x = pk2(y[0], y[1]); p.y = pk2(y[2], y[3]); *(u32x2*)(xn + (size_t)row * D_ + lane * 4 + 256 * j) = p; }
      }
    }
    if (MODE == 0 || MODE == 1) {
#pragma unroll 1
      for (int cgp = 0; cgp < 4; ++cgp) {
        f32x4 a[RPW];
#pragma unroll
        for (int r = 0; r < RPW; ++r) a[r] = (f32x4){0.f, 0.f, 0.f, 0.f};
#pragma unroll
        for (int kk = 0; kk < 16; ++kk) {
          const f32x4 w = *(const LAS f32x4*)(wl + (lane + 64 * kk) * NSP + cgp * 4);
#pragma unroll
          for (int r = 0; r < RPW; ++r) a[r] += w * u[r][kk];
        }
#pragma unroll
        for (int r = 0; r < RPW; ++r)
#pragma unroll
          for (int i = 0; i < 4; ++i) a[r][i] = wave_sum(a[r][i]);
        if (lane < RPW) { const f32x4 v = lane == 0 ? a[0] : a[1]; *(f32x4*)((float*)(F.ws + WS_SK) + (size_t)(it * RPW + lane) * 16 + cgp * 4) = v; }
      }
    }
    if (MODE == 2) {
      f32x4 ag[RPW];
#pragma unroll
      for (int r = 0; r < RPW; ++r) ag[r] = (f32x4){0.f, 0.f, 0.f, 0.f};
#pragma unroll
      for (int kk = 0; kk < 16; ++kk) {
        const f32x4 w = *(const LAS f32x4*)(wl + (lane + 64 * kk) * NSP);
#pragma unroll
        for (int r = 0; r < RPW; ++r) ag[r] += w * u[r][kk];
      }
      const float* bg = A.in[25] + l * 4; const float* br = A.in[27] + l * 32;
#pragma unroll
      for (int r = 0; r < RPW; ++r) {
        const int row = it * RPW + r;
        float g4[4];
#pragma unroll
        for (int i = 0; i < 4; ++i) g4[i] = wave_sum(ag[r][i]) + bg[i];
        int gi = 0; float gm = g4[0];
#pragma unroll
        for (int i = 1; i < 4; ++i) if (g4[i] > gm) { gm = g4[i]; gi = i; }
        float se = 0.f;
#pragma unroll
        for (int i = 0; i < 4; ++i) se += __expf(g4[i] - gm);
        const float pg = 1.f / se;
        f32x4 e0v = {0.f, 0.f, 0.f, 0.f}, e1v = {0.f, 0.f, 0.f, 0.f};
#pragma unroll
        for (int kk = 0; kk < 16; ++kk) {
          const LAS float* wp = wl + (lane + 64 * kk) * NSP + 4 + gi * 8;
          e0v += *(const LAS f32x4*)wp * u[r][kk]; e1v += *(const LAS f32x4*)(wp + 4) * u[r][kk];
        }
        float le[8];
#pragma unroll
        for (int i = 0; i < 4; ++i) { le[i] = wave_sum(e0v[i]) + br[gi * 8 + i]; le[4 + i] = wave_sum(e1v[i]) + br[gi * 8 + 4 + i]; }
        float m0 = -3.4e38f, m1 = -3.4e38f; int e0 = 0, e1 = 0;
#pragma unroll
        for (int i = 0; i < 8; ++i) { const float x = le[i];
          if (x > m0) { m1 = m0; e1 = e0; m0 = x; e0 = i; } else if (x > m1) { m1 = x; e1 = i; } }
        const float p1 = __expf(m1 - m0), w0 = pg / (1.f + p1), w1 = pg * p1 / (1.f + p1);
        const int E0 = gi * 8 + e0, E1 = gi * 8 + e1;
        if (lane == 0) {
          const int ls0 = __hip_atomic_fetch_add(&lcnt[E0], 1, __ATOMIC_RELAXED, __HIP_MEMORY_SCOPE_WORKGROUP), ls1 = __hip_atomic_fetch_add(&lcnt[E1], 1, __ATOMIC_RELAXED, __HIP_MEMORY_SCOPE_WORKGROUP);
          const int ri = __hip_atomic_fetch_add(&lcnt[32], 1, __ATOMIC_RELAXED, __HIP_MEMORY_SCOPE_WORKGROUP);
          rinfo[ri * 4] = row; rinfo[ri * 4 + 1] = E0 | (E1 << 8); rinfo[ri * 4 + 2] = ls0; rinfo[ri * 4 + 3] = ls1;
          float* tw = (float*)(F.ws + WS_TOK) + 4 * T_; tw[row * 2] = w0; tw[row * 2 + 1] = w1;
        }
      }
    }
  }
  if (MODE == 2) {
    __syncthreads();
    if (F.tid < 32) { const int c = lcnt[F.tid]; lcnt[64 + F.tid] = c ? atomicAdd((int*)(F.ws + WS_CTL) + l * 32 + F.tid, c) : 0; }
    __syncthreads();
    const int nr = lcnt[32];
    int* list = (int*)(F.ws + WS_LIST); int* te = (int*)(F.ws + WS_TOK); int* ts = te + 2 * T_;
    for (int r = F.tid; r < nr; r += NTHR) {
      const int row = rinfo[r * 4], ee = rinfo[r * 4 + 1], E0 = ee & 255, E1 = ee >> 8;
      const int s0 = lcnt[64 + E0] + rinfo[r * 4 + 2], s1 = lcnt[64 + E1] + rinfo[r * 4 + 3];
      list[E0 * T_ + s0] = row; list[E1 * T_ + s1] = row;
      te[row * 2] = E0; te[row * 2 + 1] = E1; ts[row * 2] = s0; ts[row * 2 + 1] = s1;
    }
  }
}

template <bool GATHER_> struct MoeSched {
  static constexpr bool GATHER = GATHER_;
  const LAS int* tb; const LAS int* cn; const int* list; int G, c, K, ntot;
  __device__ bool next(int i, pg8::Unit& u) const {
    const int L = i * G + c; if (L >= ntot * 4) return false;
    const int rt = L >> 2, pc = L & 3; const int e = tb[80 + rt];
    u.pm = rt; u.pc = pc; u.pn = e * 4 + pc; u.e = e; u.slot0 = (rt - tb[e]) * 256; u.cnt = cn[e]; return true;
  }
  __device__ __forceinline__ unsigned aoff(const pg8::Unit& u, int row, int col) const {
    if (GATHER) { const int s = u.slot0 + row; const int tok = s < u.cnt ? list[u.e * T_ + s] : 0; return (unsigned)((tok * K + col) * 2); }
    return (unsigned)(((u.pm * 256 + row) * K + col) * 2);
  }
};
__device__ __forceinline__ void moe_tables(Frame& F, int l, LAS int* tb, LAS int* cn) {
  if (F.tid == 0) { const int* cnt = (const int*)(F.ws + WS_CTL) + l * 32; int acc = 0;
#pragma unroll 1
    for (int e = 0; e < 32; ++e) { const int c = cnt[e]; tb[e] = acc; cn[e] = c; const int nt = (c + 255) >> 8;
#pragma unroll 1
      for (int j = 0; j < nt; ++j) tb[80 + acc + j] = e;
      acc += nt; }
    tb[32] = acc; }
  __syncthreads();
}


__device__ __forceinline__ f32x4 mfma16(bf16x8 a, bf16x8 b, f32x4 c) { return __builtin_amdgcn_mfma_f32_16x16x32_bf16(a, b, c, 0, 0, 0); }
template <int K>
__device__ __forceinline__ f32x4 mma_tile(const LAS bf16_t* A, int lda, const LAS bf16_t* Bt, int ldb, int lane, f32x4 acc) {
  const int r = lane & 15, q = lane >> 4;
#pragma unroll
  for (int kb = 0; kb < K / 32; ++kb) {
    const bf16x8 a = *(const LAS bf16x8*)(A + r * lda + kb * 32 + q * 8);
    const bf16x8 b = *(const LAS bf16x8*)(Bt + r * ldb + kb * 32 + q * 8);
    acc = mfma16(a, b, acc);
  }
  return acc;
}
__device__ __forceinline__ u32x2 pack4(f32x4 v) { u32x2 p; p.x = pk2(v[0], v[1]); p.y = pk2(v[2], v[3]); return p; }
__device__ __forceinline__ f32x4 unpack4(u32x2 p) { return (f32x4){bf2f(p.x & 0xffffu), bf2f(p.x >> 16), bf2f(p.y & 0xffffu), bf2f(p.y >> 16)}; }

__device__ __forceinline__ void ph_dn1(Frame& F, const Args& A) {
  LAS bf16_t* Kt = (LAS bf16_t*)(F.lds + 0);
  LAS bf16_t* Qt = (LAS bf16_t*)(F.lds + 17408);
  LAS bf16_t* ATT = (LAS bf16_t*)(F.lds + 34816);
  LAS bf16_t* KTt = (LAS bf16_t*)(F.lds + 44032);
  LAS float* Lm = (LAS float*)(F.lds + 62464);
  LAS float* Vs = (LAS float*)(F.lds + 79872);
  LAS bf16_t* UWt = (LAS bf16_t*)(F.lds + 62464);
  LAS float* CW = (LAS float*)(F.lds + 112640);
  LAS float* SC = (LAS float*)(F.lds + 118784);
  const bf16_t* P = (const bf16_t*)(F.ws + WS_P); const float* SK = (const float*)(F.ws + WS_SK);
  const float* conv_w = A.in[19];
  const int tid = F.tid, lane = F.lane, wave = F.wave;
  for (int u = F.bid; u < 2048; u += F.G) {
    const int h = u & 7, c = (u >> 3) & 127, b = u >> 10;
    const int t0 = b * S_ + c * 64;
    for (int i = tid; i < 1536; i += NTHR) { const int x = i >> 9, j = (i >> 7) & 3, ch = i & 127; CW[i] = conv_w[j * 3072 + x * 1024 + h * 128 + ch]; }
    if (tid < 64) {
      const float bl = SK[(size_t)(t0 + tid) * 16 + h], al = SK[(size_t)(t0 + tid) * 16 + 8 + h];
      float g = -__expf(A.in[20][h]) * softplusf_(al + A.in[21][h]);
#pragma unroll
      for (int d = 1; d < 64; d <<= 1) { const float o = __shfl_up(g, d); if (lane >= d) g += o; }
      SC[tid] = sigmoidf_(bl); SC[64 + tid] = g;
    }
    __syncthreads();
    {
      const int tok = tid >> 3, part = tid & 7, tl = c * 64 + tok;
      float ss[2];
#pragma unroll
      for (int x = 0; x < 3; ++x) {
        float acc[16];
#pragma unroll
        for (int i = 0; i < 16; ++i) acc[i] = 0.f;
#pragma unroll
        for (int j = 0; j < 4; ++j) {
          if (tl - 3 + j >= 0) {
            const bf16_t* src = P + (size_t)(t0 + tok - 3 + j) * LDP1 + x * 1024 + h * 128 + part * 16;
            const u32x4 v0 = *(const u32x4*)src, v1 = *(const u32x4*)(src + 8);
            const LAS float* w = CW + (x * 4 + j) * 128 + part * 16;
            const unsigned vv[8] = {v0.x, v0.y, v0.z, v0.w, v1.x, v1.y, v1.z, v1.w};
#pragma unroll
            for (int i = 0; i < 8; ++i) { acc[2*i] += w[2*i] * bf2f(vv[i] & 0xffffu); acc[2*i+1] += w[2*i+1] * bf2f(vv[i] >> 16); }
          }
        }
        float s2 = 0.f;
#pragma unroll
        for (int i = 0; i < 16; ++i) { acc[i] = siluf_(acc[i]); s2 += acc[i] * acc[i]; }
        if (x < 2) {
          s2 += __shfl_xor(s2, 1); s2 += __shfl_xor(s2, 2); s2 += __shfl_xor(s2, 4);
          float sc = rsqrtf(s2 + EPS); if (x == 0) sc *= 0.08838834764831845f;
          LAS bf16_t* dst = (x == 0 ? Qt : Kt) + tok * 136 + part * 16;
          u32x4 o0, o1;
          o0.x = pk2(acc[0] * sc, acc[1] * sc); o0.y = pk2(acc[2] * sc, acc[3] * sc); o0.z = pk2(acc[4] * sc, acc[5] * sc); o0.w = pk2(acc[6] * sc, acc[7] * sc);
          o1.x = pk2(acc[8] * sc, acc[9] * sc); o1.y = pk2(acc[10] * sc, acc[11] * sc); o1.z = pk2(acc[12] * sc, acc[13] * sc); o1.w = pk2(acc[14] * sc, acc[15] * sc);
          *(LAS u32x4*)dst = o0; *(LAS u32x4*)(dst + 8) = o1;
        } else {
          LAS float* dst = Vs + tok * 128 + part * 16;
#pragma unroll
          for (int i = 0; i < 4; ++i) *(LAS f32x4*)(dst + 4 * i) = (f32x4){acc[4*i], acc[4*i+1], acc[4*i+2], acc[4*i+3]};
        }
        (void)ss;
      }
    }
    __syncthreads();
    {
      const int q = lane >> 4, cc = lane & 15;
#pragma unroll 1
      for (int m = 0; m < 4; ++m) {
        const int id = wave * 4 + m, mat = id >> 4, ti = (id >> 2) & 3, tj = id & 3;
        f32x4 acc = {0.f, 0.f, 0.f, 0.f};
        if (tj <= ti) acc = mma_tile<128>((mat == 0 ? Kt : Qt) + ti * 16 * 136, 136, Kt + tj * 16 * 136, 136, lane, acc);
        const int j = tj * 16 + cc; const float gj = SC[64 + j];
#pragma unroll
        for (int r = 0; r < 4; ++r) {
          const int i = ti * 16 + 4 * q + r; const float d = __expf(SC[64 + i] - gj);
          if (mat == 0) Lm[i * 68 + j] = (i > j) ? SC[i] * acc[r] * d : 0.f;
          else ATT[i * 72 + j] = (bf16_t)f2bf((i >= j) ? acc[r] * d : 0.f);
        }
      }
    }
    __syncthreads();
    float x[64];
    if (tid < 256) {
      const int n = tid;
      unsigned lofs = 0; asm volatile("" : "+v"(lofs));
      const LAS float* Lq = (const LAS float*)((const LAS unsigned char*)Lm + lofs);
#pragma unroll
      for (int i = 0; i < 64; ++i) {
        float a = (n < 128) ? SC[i] * Vs[i * 128 + n] : SC[i] * __expf(SC[64 + i]) * bf2f(Kt[i * 136 + (n - 128)]);
#pragma unroll
        for (int j4 = 0; j4 < (i + 3) / 4; ++j4) {
          const f32x4 l = *(const LAS f32x4*)(Lq + i * 68 + 4 * j4);
#pragma unroll
          for (int jj = 0; jj < 4; ++jj) if (4 * j4 + jj < i) a -= l[jj] * x[4 * j4 + jj];
        }
        asm volatile("" : "+v"(a) :: "memory");
        x[i] = a;
      }
    } else {
      const float gl = SC[64 + 63];
      for (int e = tid - 256; e < 8192; e += 256) { const int tok = e >> 7, dk = e & 127; KTt[dk * 72 + tok] = (bf16_t)f2bf(bf2f(Kt[tok * 136 + dk]) * __expf(gl - SC[64 + tok])); }
    }
    __syncthreads();
    if (tid < 256) {
#pragma unroll
      for (int i8 = 0; i8 < 8; ++i8) { u32x4 o; o.x = pk2(x[8*i8], x[8*i8+1]); o.y = pk2(x[8*i8+2], x[8*i8+3]); o.z = pk2(x[8*i8+4], x[8*i8+5]); o.w = pk2(x[8*i8+6], x[8*i8+7]); *(LAS u32x4*)(UWt + tid * 72 + 8 * i8) = o; }
    }
    __syncthreads();
    {
      const int q = lane >> 4, cc = lane & 15;
      bf16_t* OL = (bf16_t*)(F.ws + WS_OLOC); bf16_t* QH = (bf16_t*)(F.ws + WS_QH) + (size_t)u * 64 * 128;
      bf16_t* BCT = (bf16_t*)(F.ws + WS_BCT) + (size_t)u * 128 * 128; bf16_t* AC = (bf16_t*)(F.ws + WS_AC) + (size_t)u * 128 * 128;
      const float egl = __expf(SC[64 + 63]);
#pragma unroll 1
      for (int m = 0; m < 24; ++m) {
        const int id = wave + 8 * m;
        f32x4 acc = {0.f, 0.f, 0.f, 0.f};
        if (id < 32) {
          const int tdv = id >> 2, tt = id & 3;
          acc = mma_tile<64>(UWt + tdv * 16 * 72, 72, ATT + tt * 16 * 72, 72, lane, acc);
          *(u32x2*)(OL + (size_t)(t0 + tt * 16 + cc) * D_ + h * 128 + tdv * 16 + 4 * q) = pack4(acc);
        } else if (id < 64) {
          const int tdk = (id - 32) >> 2, tt = id & 3, tok = tt * 16 + cc;
          acc = mma_tile<64>(UWt + (128 + tdk * 16) * 72, 72, ATT + tt * 16 * 72, 72, lane, acc);
          const u32x2 qv = *(const LAS u32x2*)(Qt + tok * 136 + tdk * 16 + 4 * q);
          const float eg = __expf(SC[64 + tok]);
          *(u32x2*)(QH + tok * 128 + tdk * 16 + 4 * q) = pack4(unpack4(qv) * eg - acc);
        } else if (id < 128) {
          const int tdk = (id - 64) >> 3, tdv = id & 7;
          acc = mma_tile<64>(KTt + tdk * 16 * 72, 72, UWt + tdv * 16 * 72, 72, lane, acc);
          *(u32x2*)(BCT + (tdv * 16 + cc) * 128 + tdk * 16 + 4 * q) = pack4(acc);
        } else {
          const int tn = (id - 128) >> 3, tm = id & 7, mm = tm * 16 + cc;
          acc = mma_tile<64>(UWt + (128 + tn * 16) * 72, 72, KTt + tm * 16 * 72, 72, lane, acc);
          f32x4 v;
#pragma unroll
          for (int r = 0; r < 4; ++r) v[r] = ((tn * 16 + 4 * q + r) == mm ? egl : 0.f) - acc[r];
          *(u32x2*)(AC + mm * 128 + 32 * (tn >> 1) + 8 * q + 4 * (tn & 1)) = pack4(v);
        }
      }
    }
    __syncthreads();
  }
}

__device__ __forceinline__ void ph_dn2(Frame& F) {
  if (F.bid >= 64) return;
  const int xcd = F.bid & 7, jj = F.bid >> 3, bh = xcd * 2 + (jj >> 2), quarter = jj & 3, b = bh >> 3, h = bh & 7;
  const int lane = F.lane, wave = F.wave, q = lane >> 4, cc = lane & 15;
  const bf16_t* AC = (const bf16_t*)(F.ws + WS_AC); bf16_t* BCT = (bf16_t*)(F.ws + WS_BCT);
  const size_t u0 = (size_t)(b * 128) * 8 + h;
  if (wave >= 4) {
    const int lw = wave - 4;
#define DN2_DMA(step) do { const bf16_t* src = AC + (u0 + 8 * (size_t)(step)) * 16384; const unsigned sb = (unsigned)((step) & 3) * 32768u; \
      _Pragma("unroll") for (int m = 0; m < 8; ++m) { const int ch = lw * 64 + lane + 256 * m, row = ch >> 4, c16 = ch & 15; \
        __builtin_amdgcn_global_load_lds((const unsigned*)(src + row * 128 + ((c16 ^ (row & 15)) << 3)), (LAS unsigned*)(F.lds + sb + lw * 1024 + m * 4096), 16, 0, 0); } } while (0)
    DN2_DMA(0); DN2_DMA(1); DN2_DMA(2);
#pragma unroll 1
    for (int k = 0; k < 128; ++k) {
      asm volatile("s_waitcnt vmcnt(16)" ::: "memory");
      __builtin_amdgcn_s_barrier();
      const int nx = k + 3 < 128 ? k + 3 : 127;
      { const bf16_t* src = AC + (u0 + 8 * (size_t)nx) * 16384; const unsigned sb = (unsigned)((k + 3) & 3) * 32768u;
#pragma unroll
        for (int m = 0; m < 8; ++m) { const int ch = lw * 64 + lane + 256 * m, row = ch >> 4, c16 = ch & 15;
          __builtin_amdgcn_global_load_lds((const unsigned*)(src + row * 128 + ((c16 ^ (row & 15)) << 3)), (LAS unsigned*)(F.lds + sb + lw * 1024 + m * 4096), 16, 0, 0); } }
    }
    asm volatile("s_waitcnt vmcnt(0)" ::: "memory");
#undef DN2_DMA
  } else if (wave >= 2) {
#pragma unroll 1
    for (int k = 0; k < 128; ++k) __builtin_amdgcn_s_barrier();
  } else {
    const int col = quarter * 32 + wave * 16 + cc;
    f32x4 S[8];
#pragma unroll
    for (int r = 0; r < 8; ++r) S[r] = (f32x4){0.f, 0.f, 0.f, 0.f};
    u32x2 bc[8], bn[8];
#pragma unroll
    for (int r = 0; r < 8; ++r) bc[r] = *(const u32x2*)(BCT + u0 * 16384 + col * 128 + 16 * r + 4 * q);
#pragma unroll 1
    for (int k = 0; k < 128; ++k) {
      __builtin_amdgcn_s_barrier();
      const size_t u = u0 + 8 * (size_t)k, un = u0 + 8 * (size_t)(k + 1 < 128 ? k + 1 : 127);
#pragma unroll
      for (int r = 0; r < 8; ++r) bn[r] = *(const u32x2*)(BCT + un * 16384 + col * 128 + 16 * r + 4 * q);
      const LAS unsigned char* slot = F.lds + (unsigned)(k & 3) * 32768u;
      u32x2 sp[8]; bf16x8 bfr[4];
#pragma unroll
      for (int r = 0; r < 8; ++r) sp[r] = pack4(S[r]);
#pragma unroll
      for (int kb = 0; kb < 4; ++kb) { u32x4 bw; bw.x = sp[2 * kb].x; bw.y = sp[2 * kb].y; bw.z = sp[2 * kb + 1].x; bw.w = sp[2 * kb + 1].y; bfr[kb] = __builtin_bit_cast(bf16x8, bw); }
      f32x4 Sn[8];
#pragma unroll
      for (int half = 0; half < 2; ++half) {
        bf16x8 af[4][4];
#pragma unroll
        for (int r = 0; r < 4; ++r)
#pragma unroll
          for (int kb = 0; kb < 4; ++kb) af[r][kb] = *(const LAS bf16x8*)(slot + (16 * (4 * half + r) + cc) * 256 + (((4 * kb + q) ^ cc) << 4));
#pragma unroll
        for (int r = 0; r < 4; ++r) {
          f32x4 a = {0.f, 0.f, 0.f, 0.f};
#pragma unroll
          for (int kb = 0; kb < 4; ++kb) a = mfma16(af[r][kb], bfr[kb], a);
          Sn[4 * half + r] = a;
        }
      }
#pragma unroll
      for (int r = 0; r < 8; ++r) { *(u32x2*)(BCT + u * 16384 + col * 128 + 16 * r + 4 * q) = sp[r]; S[r] = Sn[r] + unpack4(bc[r]); bc[r] = bn[r]; }
    }
  }
}

__device__ __forceinline__ void ph_dn3(Frame& F, const Args& A) {
  const int lane = F.lane, q = lane >> 4, cc = lane & 15, tt = F.wave & 3;
  const bf16_t* ST = (const bf16_t*)(F.ws + WS_BCT); const bf16_t* QH = (const bf16_t*)(F.ws + WS_QH); const bf16_t* OL = (const bf16_t*)(F.ws + WS_OLOC);
  const bf16_t* P = (const bf16_t*)(F.ws + WS_P); bf16_t* Y = (bf16_t*)(F.ws + WS_Y); const float* gn = A.in[22];
  for (int up = F.bid; up < 1024; up += F.G) {
    const int u = up * 2 + (F.wave >> 2), h = u & 7, c = (u >> 3) & 127, b = u >> 10;
    const size_t t = (size_t)b * S_ + c * 64 + tt * 16 + cc;
    bf16x8 bq[4];
#pragma unroll
    for (int kb = 0; kb < 4; ++kb) bq[kb] = *(const bf16x8*)(QH + (size_t)u * 8192 + (tt * 16 + cc) * 128 + kb * 32 + q * 8);
    f32x4 acc[8]; float ss = 0.f;
#pragma unroll
    for (int td = 0; td < 8; ++td) {
      acc[td] = unpack4(*(const u32x2*)(OL + t * D_ + h * 128 + td * 16 + 4 * q));
#pragma unroll
      for (int kb = 0; kb < 4; ++kb) { const bf16x8 a = *(const bf16x8*)(ST + (size_t)u * 16384 + (td * 16 + cc) * 128 + kb * 32 + q * 8); acc[td] = mfma16(a, bq[kb], acc[td]); }
#pragma unroll
      for (int r = 0; r < 4; ++r) ss += acc[td][r] * acc[td][r];
    }
    ss += __shfl_xor(ss, 16); ss += __shfl_xor(ss, 32);
    const float rstd = rsqrtf(ss * (1.f / 128.f) + EPS);
#pragma unroll
    for (int td = 0; td < 8; ++td) {
      const f32x4 z = unpack4(*(const u32x2*)(P + t * LDP1 + 3072 + h * 128 + td * 16 + 4 * q));
      const f32x4 g = *(const f32x4*)(gn + td * 16 + 4 * q);
      f32x4 y;
#pragma unroll
      for (int r = 0; r < 4; ++r) y[r] = acc[td][r] * rstd * g[r] * siluf_(z[r]);
      *(u32x2*)(Y + t * D_ + h * 128 + td * 16 + 4 * q) = pack4(y);
    }
  }
}


__device__ __forceinline__ void ph_mix0_a(Frame& F, const Args& A) {
  const bf16_t* P = (const bf16_t*)(F.ws + WS_P); const float* SK = (const float*)(F.ws + WS_SK);
  const int tid = F.tid, lane = F.lane, wave = F.wave, q = lane >> 4, cc = lane & 15;
  LAS bf16_t* XC = (LAS bf16_t*)F.lds;
  LAS float* PB = (LAS float*)(F.lds + 140 * 1024);
  for (int i = tid; i < 512; i += NTHR) { PB[i] = A.in[10][i]; PB[512 + i] = A.in[12][i]; PB[1024 + i] = softplusf_(-A.in[13][i]); }
  const bf16_t* WAT = (const bf16_t*)(F.ws + WS_GW); const bf16_t* WXT = WAT + 8 * 4096;
  for (int u = F.bid; u < 256; u += F.G) {
    const int b = u >> 7, c = u & 127, t0 = u * 64;
    __syncthreads();
    {
      const int cg = tid & 63, tr = tid >> 6, ch0 = cg * 8;
      float w[4][8], bias[8];
#pragma unroll
      for (int j = 0; j < 4; ++j) { const f32x4 a = *(const f32x4*)(A.in[7] + j * 512 + ch0), bq = *(const f32x4*)(A.in[7] + j * 512 + ch0 + 4);
        w[j][0] = a[0]; w[j][1] = a[1]; w[j][2] = a[2]; w[j][3] = a[3]; w[j][4] = bq[0]; w[j][5] = bq[1]; w[j][6] = bq[2]; w[j][7] = bq[3]; }
      { const f32x4 a = *(const f32x4*)(A.in[8] + ch0), bq = *(const f32x4*)(A.in[8] + ch0 + 4); bias[0] = a[0]; bias[1] = a[1]; bias[2] = a[2]; bias[3] = a[3]; bias[4] = bq[0]; bias[5] = bq[1]; bias[6] = bq[2]; bias[7] = bq[3]; }
      float win[3][8];
#pragma unroll
      for (int j = 0; j < 3; ++j) {
        const int tl = c * 64 + tr * 8 - 3 + j;
        u32x4 v = {0u, 0u, 0u, 0u};
        if (tl >= 0) v = *(const u32x4*)(P + (size_t)(b * S_ + tl) * LDP0 + ch0);
        win[j][0] = bf2f(v.x & 0xffffu); win[j][1] = bf2f(v.x >> 16); win[j][2] = bf2f(v.y & 0xffffu); win[j][3] = bf2f(v.y >> 16);
        win[j][4] = bf2f(v.z & 0xffffu); win[j][5] = bf2f(v.z >> 16); win[j][6] = bf2f(v.w & 0xffffu); win[j][7] = bf2f(v.w >> 16);
      }
#pragma unroll
      for (int k = 0; k < 8; ++k) {
        const int tok = tr * 8 + k;
        const u32x4 v = *(const u32x4*)(P + (size_t)(t0 + tok) * LDP0 + ch0);
        float cur[8] = {bf2f(v.x & 0xffffu), bf2f(v.x >> 16), bf2f(v.y & 0xffffu), bf2f(v.y >> 16), bf2f(v.z & 0xffffu), bf2f(v.z >> 16), bf2f(v.w & 0xffffu), bf2f(v.w >> 16)};
        float o[8];
#pragma unroll
        for (int i = 0; i < 8; ++i) o[i] = bias[i] + w[0][i] * win[0][i] + w[1][i] * win[1][i] + w[2][i] * win[2][i] + w[3][i] * cur[i];
        u32x4 pk; pk.x = pk2(o[0], o[1]); pk.y = pk2(o[2], o[3]); pk.z = pk2(o[4], o[5]); pk.w = pk2(o[6], o[7]);
        *(LAS u32x4*)(XC + tok * 520 + ch0) = pk;
#pragma unroll
        for (int i = 0; i < 8; ++i) { win[0][i] = win[1][i]; win[1][i] = win[2][i]; win[2][i] = cur[i]; }
      }
    }
    __syncthreads();
    {
      const int h = wave;
      float* HL = (float*)(F.ws + WS_HLOC); float* CPp = (float*)(F.ws + WS_CP);
#pragma unroll 1
      for (int tj = 0; tj < 4; ++tj) {
        bf16x8 fa[2], fx[2];
#pragma unroll
        for (int kb = 0; kb < 2; ++kb) { fa[kb] = *(const bf16x8*)(WAT + h * 4096 + (tj * 16 + cc) * 64 + kb * 32 + q * 8); fx[kb] = *(const bf16x8*)(WXT + h * 4096 + (tj * 16 + cc) * 64 + kb * 32 + q * 8); }
        const int ch = h * 64 + tj * 16 + 4 * q;
        const f32x4 vba = *(const LAS f32x4*)(PB + ch), vbx = *(const LAS f32x4*)(PB + 512 + ch), vsp = *(const LAS f32x4*)(PB + 1024 + ch);
        f32x4 carH = {0.f, 0.f, 0.f, 0.f}, carP = {1.f, 1.f, 1.f, 1.f};
#pragma unroll 1
        for (int tt = 0; tt < 4; ++tt) {
          const int tok = tt * 16 + cc;
          f32x4 ar = {0.f, 0.f, 0.f, 0.f}, ai = {0.f, 0.f, 0.f, 0.f};
#pragma unroll
          for (int kb = 0; kb < 2; ++kb) { const bf16x8 bx_ = *(const LAS bf16x8*)(XC + tok * 520 + h * 64 + kb * 32 + q * 8); ar = mfma16(fa[kb], bx_, ar); ai = mfma16(fx[kb], bx_, ai); }
          const u32x2 xv = *(const LAS u32x2*)(XC + tok * 520 + ch); const f32x4 xcv = unpack4(xv);
          f32x4 Aa, Bb;
#pragma unroll
          for (int r = 0; r < 4; ++r) {
            const float rg = sigmoidf_(ar[r] + vba[r]), ig = sigmoidf_(ai[r] + vbx[r]);
            const float la = -8.f * rg * vsp[r];
            Aa[r] = __expf(la); Bb[r] = sqrtf(-expm1f(2.f * la)) * (ig * xcv[r]);
          }
#pragma unroll
          for (int d = 1; d < 16; d <<= 1) {
#pragma unroll
            for (int r = 0; r < 4; ++r) { const float pa = __shfl_up(Aa[r], d, 16), pb = __shfl_up(Bb[r], d, 16); if (cc >= d) { Bb[r] = Aa[r] * pb + Bb[r]; Aa[r] = Aa[r] * pa; } }
          }
          f32x4 hl, cp;
#pragma unroll
          for (int r = 0; r < 4; ++r) { hl[r] = Bb[r] + Aa[r] * carH[r]; cp[r] = Aa[r] * carP[r]; }
          *(f32x4*)(HL + (size_t)(t0 + tok) * 512 + ch) = hl; *(f32x4*)(CPp + (size_t)(t0 + tok) * 512 + ch) = cp;
#pragma unroll
          for (int r = 0; r < 4; ++r) { carH[r] = __shfl(hl[r], 15, 16); carP[r] = __shfl(cp[r], 15, 16); }
        }
      }
    }
    LAS float* GC = (LAS float*)F.lds;
    LAS float* SEG = (LAS float*)(F.lds + 16640);
    LAS bf16_t* QT = (LAS bf16_t*)(F.lds + 18688);
    LAS bf16_t* KH = (LAS bf16_t*)(F.lds + 27904);
    LAS bf16_t* KTT = (LAS bf16_t*)(F.lds + 37120);
    LAS bf16_t* VT = (LAS bf16_t*)(F.lds + 46336);
    LAS bf16_t* ATT = (LAS bf16_t*)(F.lds + 64768);
#pragma unroll 1
    for (int hh = 0; hh < 4; ++hh) {
      const int ug = (b * 4 + hh) * 128 + c;
      __syncthreads();
      {
        const int tok = tid >> 3, dk0 = (tid & 7) * 8;
        float gl[16];
#pragma unroll
        for (int i = 0; i < 4; ++i) { const f32x4 v = *(const f32x4*)(SK + (size_t)(t0 + tok) * 16 + 4 * i); gl[4*i] = v[0]; gl[4*i+1] = v[1]; gl[4*i+2] = v[2]; gl[4*i+3] = v[3]; }
        float v[8];
        { const f32x4 b0 = *(const f32x4*)(A.in[15] + hh * 64 + dk0), b1 = *(const f32x4*)(A.in[15] + hh * 64 + dk0 + 4); v[0] = b0[0]; v[1] = b0[1]; v[2] = b0[2]; v[3] = b0[3]; v[4] = b1[0]; v[5] = b1[1]; v[6] = b1[2]; v[7] = b1[3]; }
#pragma unroll
        for (int r = 0; r < 16; ++r) { const f32x4 w0 = *(const f32x4*)(A.in[14] + r * 256 + hh * 64 + dk0), w1 = *(const f32x4*)(A.in[14] + r * 256 + hh * 64 + dk0 + 4);
          v[0] += gl[r] * w0[0]; v[1] += gl[r] * w0[1]; v[2] += gl[r] * w0[2]; v[3] += gl[r] * w0[3]; v[4] += gl[r] * w1[0]; v[5] += gl[r] * w1[1]; v[6] += gl[r] * w1[2]; v[7] += gl[r] * w1[3]; }
#pragma unroll
        for (int i = 0; i < 8; ++i) GC[tok * 65 + dk0 + i] = (fminf(v[i], 0.f) - log1pf(__expf(-fabsf(v[i])))) * (1.f / 16.f);
      }
      __syncthreads();
      float loc[8];
      { const int dk = tid & 63, sg = tid >> 6; float a = 0.f;
#pragma unroll
        for (int i = 0; i < 8; ++i) { a += GC[(sg * 8 + i) * 65 + dk]; loc[i] = a; }
        SEG[sg * 64 + dk] = a; }
      __syncthreads();
      { const int dk = tid & 63, sg = tid >> 6; float off = 0.f;
        for (int s2 = 0; s2 < sg; ++s2) off += SEG[s2 * 64 + dk];
#pragma unroll
        for (int i = 0; i < 8; ++i) GC[(sg * 8 + i) * 65 + dk] = loc[i] + off; }
      __syncthreads();
      {
        const int tok = tid >> 3, part = tid & 7, dk0 = part * 8;
        const u32x4 qv = *(const u32x4*)(P + (size_t)(t0 + tok) * LDP0 + 1024 + hh * 64 + dk0), kv = *(const u32x4*)(P + (size_t)(t0 + tok) * LDP0 + 1280 + hh * 64 + dk0);
        const unsigned qq[4] = {qv.x, qv.y, qv.z, qv.w}, kk[4] = {kv.x, kv.y, kv.z, kv.w};
        float qt[8], kh[8];
#pragma unroll
        for (int i = 0; i < 8; ++i) {
          const float g = GC[tok * 65 + dk0 + i], gl_ = GC[63 * 65 + dk0 + i];
          const float qf = bf2f((i & 1) ? (qq[i >> 1] >> 16) : (qq[i >> 1] & 0xffffu)), kf = bf2f((i & 1) ? (kk[i >> 1] >> 16) : (kk[i >> 1] & 0xffffu));
          qt[i] = qf * __expf(g) * 0.125f; kh[i] = kf * __expf(-g);
          KTT[(dk0 + i) * 72 + tok] = (bf16_t)f2bf(kf * __expf(gl_ - g));
        }
        u32x4 o; o.x = pk2(qt[0], qt[1]); o.y = pk2(qt[2], qt[3]); o.z = pk2(qt[4], qt[5]); o.w = pk2(qt[6], qt[7]);
        *(LAS u32x4*)(QT + tok * 72 + dk0) = o; *(u32x4*)((bf16_t*)(F.ws + WS_QG) + (size_t)(t0 + tok) * 256 + hh * 64 + dk0) = o;
        o.x = pk2(kh[0], kh[1]); o.y = pk2(kh[2], kh[3]); o.z = pk2(kh[4], kh[5]); o.w = pk2(kh[6], kh[7]);
        *(LAS u32x4*)(KH + tok * 72 + dk0) = o;
        const bf16_t* vsrc = P + (size_t)(t0 + tok) * LDP0 + 1536 + hh * 128 + part * 16;
        const u32x4 v0 = *(const u32x4*)vsrc, v1 = *(const u32x4*)(vsrc + 8);
        const unsigned vv[8] = {v0.x, v0.y, v0.z, v0.w, v1.x, v1.y, v1.z, v1.w};
#pragma unroll
        for (int i = 0; i < 8; ++i) { VT[(part * 16 + 2 * i) * 72 + tok] = (bf16_t)(vv[i] & 0xffffu); VT[(part * 16 + 2 * i + 1) * 72 + tok] = (bf16_t)(vv[i] >> 16); }
        if (tid < 64) ((float*)(F.ws + WS_DEC))[(size_t)ug * 64 + tid] = __expf(GC[63 * 65 + tid]);
      }
      __syncthreads();
#pragma unroll 1
      for (int m = 0; m < 2; ++m) {
        const int id = wave * 2 + m, ti = id >> 2, tj = id & 3;
        f32x4 acc = {0.f, 0.f, 0.f, 0.f};
        if (tj <= ti) acc = mma_tile<64>(QT + ti * 16 * 72, 72, KH + tj * 16 * 72, 72, lane, acc);
#pragma unroll
        for (int r = 0; r < 4; ++r) { const int i = ti * 16 + 4 * q + r, j = tj * 16 + cc; ATT[i * 72 + j] = (bf16_t)f2bf(i >= j ? acc[r] : 0.f); }
      }
      __syncthreads();
#pragma unroll 1
      for (int m = 0; m < 8; ++m) {
        const int id = wave + 8 * m;
        f32x4 acc = {0.f, 0.f, 0.f, 0.f};
        if (id < 32) {
          const int tdv = id >> 2, tt = id & 3;
          acc = mma_tile<64>(VT + tdv * 16 * 72, 72, ATT + tt * 16 * 72, 72, lane, acc);
          *(u32x2*)((bf16_t*)(F.ws + WS_OLG) + (size_t)(t0 + tt * 16 + cc) * 512 + hh * 128 + tdv * 16 + 4 * q) = pack4(acc);
        } else {
          const int tdk = (id - 32) >> 3, tdv = id & 7;
          acc = mma_tile<64>(KTT + tdk * 16 * 72, 72, VT + tdv * 16 * 72, 72, lane, acc);
          *(f32x4*)((float*)(F.ws + WS_DST) + (size_t)ug * 8192 + (tdv * 16 + cc) * 64 + tdk * 16 + 4 * q) = acc;
        }
      }
    }
  }
}
__device__ __forceinline__ void ph_mix0_b(Frame& F) {
  if (F.bid < 128) {
    const int gidx = F.bid * NTHR + F.tid, bh = gidx >> 13, e = gidx & 8191, dk = e & 63;
    const float* DST = (const float*)(F.ws + WS_DST) + (size_t)bh * 128 * 8192 + e; bf16_t* STG = (bf16_t*)(F.ws + WS_STG) + (size_t)bh * 128 * 8192 + e;
    const float* DEC = (const float*)(F.ws + WS_DEC) + (size_t)bh * 128 * 64 + dk;
    float S = 0.f;
#pragma unroll 8
    for (int c = 0; c < 128; ++c) { const float d = DEC[c * 64], ds = DST[(size_t)c * 8192]; STG[(size_t)c * 8192] = (bf16_t)f2bf(S); S = d * S + ds; }
  } else if (F.bid < 130) {
    const int idx = (F.bid - 128) * NTHR + F.tid, b = idx >> 9, ch = idx & 511;
    const float* HL = (const float*)(F.ws + WS_HLOC); const float* CPp = (const float*)(F.ws + WS_CP); float* CAR = (float*)(F.ws + WS_CAR);
    float carry = 0.f;
#pragma unroll 8
    for (int c = 0; c < 128; ++c) { const size_t t = (size_t)b * S_ + c * 64 + 63; const float a = CPp[t * 512 + ch], hb = HL[t * 512 + ch]; CAR[(size_t)(b * 128 + c) * 512 + ch] = carry; carry = a * carry + hb; }
  }
}
__device__ __forceinline__ void ph_mix0_c(Frame& F, const Args& A) {
  const bf16_t* P = (const bf16_t*)(F.ws + WS_P); bf16_t* Y = (bf16_t*)(F.ws + WS_Y);
  const int tid = F.tid, lane = F.lane, wave = F.wave, q = lane >> 4, cc = lane & 15;
  for (int u = F.bid; u < 256; u += F.G) {
    const int b = u >> 7, c = u & 127, t0 = u * 64;
    {
      const int tok = tid >> 3, part = tid & 7; const size_t t = (size_t)t0 + tok;
      const float* HL = (const float*)(F.ws + WS_HLOC) + t * 512; const float* CPp = (const float*)(F.ws + WS_CP) + t * 512; const float* CAR = (const float*)(F.ws + WS_CAR) + (size_t)u * 512;
#pragma unroll 4
      for (int k = 0; k < 16; ++k) {
        const int ch = k * 32 + part * 4;
        const f32x4 hl = *(const f32x4*)(HL + ch), cp = *(const f32x4*)(CPp + ch), ca = *(const f32x4*)(CAR + ch);
        const f32x4 ga = unpack4(*(const u32x2*)(P + t * LDP0 + 512 + ch));
        f32x4 y;
#pragma unroll
        for (int r = 0; r < 4; ++r) y[r] = gelu_tanh(ga[r]) * (hl[r] + cp[r] * ca[r]);
        *(u32x2*)(Y + t * D_ + ch) = pack4(y);
      }
    }
    {
      const int hh = wave >> 1, ug = (b * 4 + hh) * 128 + c;
      const bf16_t* STG = (const bf16_t*)(F.ws + WS_STG) + (size_t)ug * 8192; const bf16_t* QG = (const bf16_t*)(F.ws + WS_QG); const bf16_t* OLG = (const bf16_t*)(F.ws + WS_OLG);
#pragma unroll 1
      for (int m = 0; m < 2; ++m) {
        const int tt = (wave & 1) * 2 + m; const size_t t = (size_t)t0 + tt * 16 + cc;
        bf16x8 bq[2];
#pragma unroll
        for (int kb = 0; kb < 2; ++kb) bq[kb] = *(const bf16x8*)(QG + t * 256 + hh * 64 + kb * 32 + q * 8);
        f32x4 acc[8]; float ss = 0.f;
#pragma unroll
        for (int td = 0; td < 8; ++td) {
          acc[td] = unpack4(*(const u32x2*)(OLG + t * 512 + hh * 128 + td * 16 + 4 * q));
#pragma unroll
          for (int kb = 0; kb < 2; ++kb) { const bf16x8 a = *(const bf16x8*)(STG + (td * 16 + cc) * 64 + kb * 32 + q * 8); acc[td] = mfma16(a, bq[kb], acc[td]); }
#pragma unroll
          for (int r = 0; r < 4; ++r) ss += acc[td][r] * acc[td][r];
        }
        ss += __shfl_xor(ss, 16); ss += __shfl_xor(ss, 32);
        const float rstd = rsqrtf(ss * (1.f / 128.f) + EPS);
#pragma unroll
        for (int td = 0; td < 8; ++td) {
          const f32x4 og = unpack4(*(const u32x2*)(P + t * LDP0 + 2048 + hh * 128 + td * 16 + 4 * q));
          const f32x4 g = *(const f32x4*)(A.in[16] + td * 16 + 4 * q);
          f32x4 y;
#pragma unroll
          for (int r = 0; r < 4; ++r) y[r] = acc[td][r] * rstd * g[r] * siluf_(og[r]);
          *(u32x2*)(Y + t * D_ + 512 + hh * 128 + td * 16 + 4 * q) = pack4(y);
        }
      }
    }
  }
}


#define XB_TMO      128
#define XB_XCNT(j)  (256  + 64 * (j))
#define XB_XSUB(j)  (1280 + 64 * (j))
#define XB_XGEN(j)  (2304 + 64 * (j))
#define XB_TOP      3328
#define XB_TOPGEN   3392
#define XCD_BAR_WORDS 3456
#define XB_SPIN_CAP (1u << 18)
__device__ __forceinline__ unsigned xb_ld(unsigned* p)              { return __hip_atomic_load(p, __ATOMIC_RELAXED, __HIP_MEMORY_SCOPE_AGENT); }
__device__ __forceinline__ unsigned xb_add(unsigned* p, unsigned v) { return __hip_atomic_fetch_add(p, v, __ATOMIC_RELAXED, __HIP_MEMORY_SCOPE_AGENT); }
__device__ __forceinline__ unsigned xb_xcc_id() { return (unsigned)__builtin_amdgcn_s_getreg((3 << 11) | 20) & 0xFu; }
#define XB_SPIN(cond, bar) do { unsigned _sp = 0; while (cond) { __builtin_amdgcn_s_sleep(1); \
    if ((++_sp & 255u) == 0u) { if (xb_ld(&(bar)[XB_TMO])) break; if (_sp > XB_SPIN_CAP) { atomicAdd(&(bar)[XB_TMO], 1u); break; } } } } while (0)
struct XcdBarrier { unsigned* bar; unsigned x; volatile LAS unsigned* st; };
__device__ __forceinline__ XcdBarrier xcd_barrier_post(unsigned* bar, volatile LAS unsigned* st) {
    XcdBarrier b; b.bar = bar; b.x = xb_xcc_id(); b.st = st;
    if (threadIdx.x == 0) (void)xb_add(&bar[XB_XCNT(b.x)], 1u);
    return b;
}
__device__ __forceinline__ void xcd_barrier_complete(unsigned* bar, unsigned x, unsigned& nloc, unsigned& nx) {
    const unsigned G = gridDim.x * gridDim.y * gridDim.z;
    unsigned sum, cnt, mine, sp = 0u;
    for (;;) {
        sum = 0u; cnt = 0u; mine = 0u;
#pragma unroll
        for (unsigned j = 0; j < 16; ++j) { const unsigned c = xb_ld(&bar[XB_XCNT(j)]); sum += c; cnt += (c > 0u) ? 1u : 0u; mine = (j == x) ? c : mine; }
        if (sum == G) break;
        __builtin_amdgcn_s_sleep(1);
        if ((++sp & 255u) == 0u) { if (xb_ld(&bar[XB_TMO])) break; if (sp > XB_SPIN_CAP) { atomicAdd(&bar[XB_TMO], 1u); break; } }
    }
    nloc = mine > 0u ? mine : 1u; nx = cnt > 0u ? cnt : 1u;
}
__device__ __forceinline__ void xcd_barrier(const XcdBarrier& b) {
    asm volatile("s_waitcnt vmcnt(0)" ::: "memory");
    __syncthreads();
    if (threadIdx.x == 0) {
        unsigned* bar = b.bar;
        __builtin_amdgcn_s_waitcnt(0);
        unsigned nloc = b.st[0], nx = b.st[1];
        if (nloc == 0u) { xcd_barrier_complete(bar, b.x, nloc, nx); b.st[0] = nloc; b.st[1] = nx; }
        const unsigned old = xb_add(&bar[XB_XSUB(b.x)], 1u);
        const unsigned gen = old / nloc;
        if (old + 1u == (gen + 1u) * nloc) {
            __builtin_amdgcn_fence(__ATOMIC_RELEASE, "agent");
            asm volatile("s_waitcnt vmcnt(0)" ::: "memory");
            const unsigned og = xb_add(&bar[XB_TOP], 1u);
            const unsigned tg = og / nx;
            if (og + 1u == (tg + 1u) * nx) xb_add(&bar[XB_TOPGEN], 1u);
            else XB_SPIN(xb_ld(&bar[XB_TOPGEN]) == tg, bar);
            __builtin_amdgcn_fence(__ATOMIC_ACQUIRE, "agent");
            xb_add(&bar[XB_XGEN(b.x)], 1u);
            asm volatile("s_waitcnt vmcnt(0)" ::: "memory");
        } else {
            XB_SPIN(xb_ld(&bar[XB_XGEN(b.x)]) == gen, bar);
            __builtin_amdgcn_fence(__ATOMIC_ACQUIRE, "agent");
            asm volatile("s_waitcnt vmcnt(0)" ::: "memory");
        }
    }
    __syncthreads();
}

enum { PH_PRO = 0, PH_N1_0, PH_GIN_0, PH_MIXA_0, PH_MIXB_0, PH_MIXC_0, PH_GOUT_0, PH_N2_0, PH_MOE1_0, PH_MOE2_0, PH_N1_1, PH_GIN_1, PH_MIXA_1, PH_MIXB_1, PH_MIXC_1, PH_GOUT_1, PH_N2_1, PH_MOE1_1, PH_MOE2_1, PH_FINAL, PH_COUNT };

constexpr unsigned DUP_MASK = 0u;
#define SEAM(k) do { if ((k) == PH_N1_0) grid.sync(); else xcd_barrier(xb); } while (0)
#define PHASE(k, ...) do { if (lo <= (k) && (k) < hi) { if ((k) != lo) SEAM(k); { __VA_ARGS__ } if ((DUP_MASK >> (k)) & 1u) { xcd_barrier(xb); { __VA_ARGS__ } } } } while (0)
template <int L>
__device__ __forceinline__ void layer_phases(Frame& F, const Args& args, cg::grid_group& grid, const XcdBarrier& xb, int lo, int hi, LAS int* tb, LAS int* cn) {
  constexpr int B = L * (PH_N1_1 - PH_N1_0);
  PHASE(B + PH_N1_0, if (L == 0) ph_norm<0>(F, args, 0); else { convert_moe(F, args, 1); __syncthreads(); ph_norm<1>(F, args, 1); });
  PHASE(B + PH_GIN_0,
    pg8::StaticOrder S; S.init(T_, L == 0 ? LDP0 : LDP1, D_, F.G, F.bid);
    pg8::EpiBf16 E{(bf16_t*)(F.ws + WS_P), L == 0 ? LDP0 : LDP1};
    pg8::gemm_phase<pg8::EpiBf16, pg8::StaticOrder, true>(F.lds, (const bf16_t*)(F.ws + WS_XN), (const bf16_t*)(F.ws + (L == 0 ? WS_WIN0 : WS_WIN1)), D_, S, E);
  );
  if (L == 0) {
    PHASE(PH_MIXA_0, ph_mix0_a(F, args););
    PHASE(PH_MIXB_0, ph_mix0_b(F););
    PHASE(PH_MIXC_0, ph_mix0_c(F, args););
  }
  if (L == 1) {
    PHASE(PH_MIXA_1, ph_dn1(F, args););
    PHASE(PH_MIXB_1, ph_dn2(F););
    PHASE(PH_MIXC_1, ph_dn3(F, args););
  }
  PHASE(B + PH_GOUT_0,
    pg8::StaticOrder S; S.init(T_, D_, D_, F.G, F.bid);
    pg8::EpiResGate E{L == 0 ? args.in[0] : F.out, F.out, (const float*)(F.ws + WS_MOD) + L * 2 * 6144 + 2 * 1024};
    pg8::gemm_phase<pg8::EpiResGate, pg8::StaticOrder, false>(F.lds, (const bf16_t*)(F.ws + WS_Y), (const bf16_t*)(F.ws + (L == 0 ? WS_WOUT0 : WS_WOUT1)), D_, S, E);
  );
  PHASE(B + PH_N2_0, ph_norm<2>(F, args, L););
  PHASE(B + PH_MOE1_0,
    moe_tables(F, L, tb, cn);
    MoeSched<true> S{tb, cn, (const int*)(F.ws + WS_LIST), F.G, F.bid, D_, tb[32]};
    pg8::EpiSwiglu E{(bf16_t*)(F.ws + WS_HMID)};
    pg8::gemm_phase<pg8::EpiSwiglu, MoeSched<true>, true>(F.lds, (const bf16_t*)(F.ws + WS_XN), (const bf16_t*)(F.ws + WS_W13), D_, S, E);
  );
  PHASE(B + PH_MOE2_0,
    moe_tables(F, L, tb, cn);
    MoeSched<false> S{tb, cn, (const int*)(F.ws + WS_LIST), F.G, F.bid, 512, tb[32]};
    pg8::EpiBf16 E{(bf16_t*)(F.ws + WS_YB), D_};
    pg8::gemm_phase<pg8::EpiBf16, MoeSched<false>, true>(F.lds, (const bf16_t*)(F.ws + WS_HMID), (const bf16_t*)(F.ws + WS_W2), 512, S, E);
  );
}

__global__ void __launch_bounds__(NTHR, 2) k_fwd(Args args) {
  extern __shared__ __attribute__((aligned(16))) unsigned char lds_raw[];
  cg::grid_group grid = cg::this_grid();
  Frame F;
  F.lds = (LAS unsigned char*)lds_raw;
  F.tid = threadIdx.x; F.lane = F.tid & 63; F.wave = __builtin_amdgcn_readfirstlane(F.tid >> 6);
  F.G = gridDim.x; F.bid = blockIdx.x;
  F.out = args.out; F.ws = args.ws;
  LAS int* tb = (LAS int*)(F.lds + 132 * 1024); LAS int* cn = tb + 40;
  const int lo = args.ph_lo, hi = args.ph_hi;
  volatile LAS unsigned* xst = (volatile LAS unsigned*)(F.lds + LDS_BYTES - 16);
  if (F.tid < 4) xst[F.tid] = 0u;
  __syncthreads();
  const XcdBarrier xb = xcd_barrier_post((unsigned*)(F.ws + WS_CTL + 16384), xst);
  PHASE(PH_PRO, ph_prologue(F, args); convert_moe(F, args, 0););
  layer_phases<0>(F, args, grid, xb, lo, hi, tb, cn);
  layer_phases<1>(F, args, grid, xb, lo, hi, tb, cn);
  PHASE(PH_FINAL, ph_norm<3>(F, args, 1););
}

__device__ __forceinline__ float ldb(const bf16_t* p, size_t i) { return bf2f(p[i]); }
__global__ __launch_bounds__(512) void k_rg_gates(const bf16_t* P, const float* conv_w, const float* conv_b, const float* wa, const float* ba, const float* wx, const float* bx, const float* lam, float* Aout, float* Bout) {
  __shared__ float xc[512];
  int t = blockIdx.x, ch = threadIdx.x, tl = t % S_;
  float v = conv_b[ch];
#pragma unroll
  for (int j = 0; j < 4; ++j) { int tt = tl - 3 + j; if (tt >= 0) v += conv_w[j * 512 + ch] * ldb(P, (size_t)(t - 3 + j) * LDP0 + ch); }
  xc[ch] = v;
  __syncthreads();
  int h = ch >> 6, jj = ch & 63;
  float r = ba[ch], ii = bx[ch];
  const float* wap = wa + h * 4096 + jj; const float* wxp = wx + h * 4096 + jj;
  for (int i = 0; i < 64; ++i) { float x = xc[h * 64 + i]; r += x * wap[i * 64]; ii += x * wxp[i * 64]; }
  r = sigmoidf_(r); ii = sigmoidf_(ii);
  float log_a = -8.f * r * softplusf_(-lam[ch]);
  float a = __expf(log_a);
  float bb = sqrtf(-expm1f(2.f * log_a)) * (ii * v);
  Aout[(size_t)t * 512 + ch] = a; Bout[(size_t)t * 512 + ch] = bb;
}
__global__ __launch_bounds__(64) void k_rg_scan(const float* Ain, const float* Bin, const bf16_t* P, bf16_t* Y) {
  int idx = blockIdx.x * 64 + threadIdx.x; int b = idx >> 9, ch = idx & 511;
  float h = 0.f;
  size_t t0 = (size_t)b * S_;
#pragma unroll 8
  for (int t = 0; t < S_; ++t) {
    float a = Ain[(t0 + t) * 512 + ch], bb = Bin[(t0 + t) * 512 + ch], ga = ldb(P, (t0 + t) * LDP0 + 512 + ch);
    h = a * h + bb;
    Y[(t0 + t) * D_ + ch] = (bf16_t)f2bf(gelu_tanh(ga) * h);
  }
}
__global__ __launch_bounds__(256) void k_gla_lg(const float* SK, const float* wg2, const float* bg2, float* LG) {
  int t = blockIdx.x, n = threadIdx.x;
  float v = bg2[n];
#pragma unroll
  for (int r = 0; r < 16; ++r) v += SK[(size_t)t * 16 + r] * wg2[r * 256 + n];
  float ls = fminf(v, 0.f) - log1pf(__expf(-fabsf(v)));
  LG[(size_t)t * 256 + n] = ls * (1.f / 16.f);
}
__global__ __launch_bounds__(128) void k_gla_rec(const bf16_t* P, const float* LG, float* O) {
  int b = blockIdx.x >> 2, h = blockIdx.x & 3, j = threadIdx.x;
  float s[64];
#pragma unroll
  for (int d = 0; d < 64; ++d) s[d] = 0.f;
  for (int t = 0; t < S_; ++t) {
    size_t row = (size_t)b * S_ + t;
    const bf16_t* q = P + row * LDP0 + 1024 + h * 64;
    const bf16_t* k = P + row * LDP0 + 1280 + h * 64;
    const float* lg = LG + row * 256 + h * 64;
    float v = ldb(P, row * LDP0 + 1536 + h * 128 + j);
    float o = 0.f;
#pragma unroll
    for (int d = 0; d < 64; ++d) { s[d] = __expf(lg[d]) * s[d] + bf2f(k[d]) * v; o += bf2f(q[d]) * s[d]; }
    O[row * 512 + h * 128 + j] = o * 0.125f;
  }
}
__global__ __launch_bounds__(256) void k_head_norm_gate(const float* O, int ldo, const float* g, const bf16_t* Pgate, int ldp, int gate_off, bf16_t* Y, int y_off, int nheads) {
  int w = blockIdx.x * 4 + (threadIdx.x >> 6), lane = threadIdx.x & 63;
  int t = w / nheads, h = w % nheads;
  float o0 = O[(size_t)t * ldo + h * 128 + lane], o1 = O[(size_t)t * ldo + h * 128 + 64 + lane];
  float ss = wave_sum(o0 * o0 + o1 * o1);
  float r = rsqrtf(ss * (1.f / 128.f) + EPS);
  float g0 = ldb(Pgate, (size_t)t * ldp + gate_off + h * 128 + lane), g1 = ldb(Pgate, (size_t)t * ldp + gate_off + h * 128 + 64 + lane);
  Y[(size_t)t * D_ + y_off + h * 128 + lane] = (bf16_t)f2bf(o0 * r * g[lane] * siluf_(g0));
  Y[(size_t)t * D_ + y_off + h * 128 + 64 + lane] = (bf16_t)f2bf(o1 * r * g[64 + lane] * siluf_(g1));
}
__global__ __launch_bounds__(256) void k_dn_prep(const bf16_t* P, const float* SK, const float* conv_w, const float* a_log, const float* dt_bias, float* QN, float* KN, float* V, float* BETA, float* G) {
  __shared__ float buf[3072];
  int t = blockIdx.x, tid = threadIdx.x, tl = t % S_;
  for (int c = tid; c < 3072; c += 256) {
    float v = 0.f;
#pragma unroll
    for (int j = 0; j < 4; ++j) { int tt = tl - 3 + j; if (tt >= 0) v += conv_w[j * 3072 + c] * ldb(P, (size_t)(t - 3 + j) * LDP1 + c); }
    buf[c] = siluf_(v);
  }
  __syncthreads();
  int w = tid >> 6, lane = tid & 63;
  for (int gi = w * 4; gi < w * 4 + 4; ++gi) {
    float x0 = buf[gi * 128 + lane], x1 = buf[gi * 128 + 64 + lane];
    float ss = wave_sum(x0 * x0 + x1 * x1);
    float sc = rsqrtf(ss + EPS);
    if (gi < 8) { sc *= 0.08838834764831845f; QN[(size_t)t * D_ + gi * 128 + lane] = x0 * sc; QN[(size_t)t * D_ + gi * 128 + 64 + lane] = x1 * sc; }
    else { int c = (gi - 8) * 128; KN[(size_t)t * D_ + c + lane] = x0 * sc; KN[(size_t)t * D_ + c + 64 + lane] = x1 * sc; }
  }
  for (int c = tid; c < 1024; c += 256) V[(size_t)t * D_ + c] = buf[2048 + c];
  if (tid < 8) {
    BETA[t * 8 + tid] = sigmoidf_(SK[(size_t)t * 16 + tid]);
    G[t * 8 + tid] = -__expf(a_log[tid]) * softplusf_(SK[(size_t)t * 16 + 8 + tid] + dt_bias[tid]);
  }
}
__global__ __launch_bounds__(128) void k_dn_rec(const float* QN, const float* KN, const float* V, const float* BETA, const float* G, float* O) {
  int b = blockIdx.x >> 3, h = blockIdx.x & 7, j = threadIdx.x;
  float s[128];
#pragma unroll
  for (int d = 0; d < 128; ++d) s[d] = 0.f;
  for (int t = 0; t < S_; ++t) {
    size_t row = (size_t)b * S_ + t;
    const float* q = QN + row * D_ + h * 128;
    const float* k = KN + row * D_ + h * 128;
    float v = V[row * D_ + h * 128 + j];
    float dec = __expf(G[row * 8 + h]), beta = BETA[row * 8 + h];
    float kd = 0.f;
#pragma unroll
    for (int d = 0; d < 128; ++d) { s[d] *= dec; kd += k[d] * s[d]; }
    float vn = beta * (v - kd);
    float o = 0.f;
#pragma unroll
    for (int d = 0; d < 128; ++d) { s[d] += k[d] * vn; o += q[d] * s[d]; }
    O[row * D_ + h * 128 + j] = o;
  }
}

extern "C" void kernel_launch(void* const* d_in, const int* in_sizes, int n_in, void* d_out, int out_size, void* d_ws, size_t ws_size, hipStream_t stream) {
  static int grid = 0;
  if (grid == 0) {
    if (n_in != 32 || ws_size < WS_END) { fprintf(stderr, "kernel_launch: bad inputs / workspace (%d inputs, ws %zu < %zu)\n", n_in, ws_size, (size_t)WS_END); grid = -1; return; }
    int dev = 0, cus = 0, per_cu = 0;
    hipGetDevice(&dev); hipDeviceGetAttribute(&cus, hipDeviceAttributeMultiprocessorCount, dev);
    if (hipFuncSetAttribute((const void*)k_fwd, hipFuncAttributeMaxDynamicSharedMemorySize, LDS_BYTES) != hipSuccess) { fprintf(stderr, "hipFuncSetAttribute failed\n"); grid = -1; return; }
    if (hipOccupancyMaxActiveBlocksPerMultiprocessor(&per_cu, (const void*)k_fwd, NTHR, LDS_BYTES) != hipSuccess || per_cu < 1) { fprintf(stderr, "occupancy query failed (%d)\n", per_cu); grid = -1; return; }
    grid = cus;
  }
  if (grid < 0) return;
  if (hipMemsetAsync((char*)d_ws + WS_CTL + 16384, 0, XCD_BAR_WORDS * 4, stream) != hipSuccess) { fprintf(stderr, "memset of barrier words failed\n"); return; }
  Args a{};
  for (int i = 0; i < 32; ++i) a.in[i] = (const float*)d_in[i];
  a.out = (float*)d_out; a.ws = (unsigned char*)d_ws;
  auto run = [&](int lo, int hi) {
    a.ph_lo = lo; a.ph_hi = hi; void* kargs[] = {&a};
    hipError_t e = hipLaunchCooperativeKernel((const void*)k_fwd, dim3(grid), dim3(NTHR), kargs, LDS_BYTES, stream);
    if (e != hipSuccess) fprintf(stderr, "cooperative launch failed: %s\n", hipGetErrorString(e));
  };
  unsigned char* ws = (unsigned char*)d_ws;
  const bf16_t* P = (const bf16_t*)(ws + WS_P); bf16_t* Y = (bf16_t*)(ws + WS_Y); const float* SK = (const float*)(ws + WS_SK);
  float* R0 = (float*)(ws + WS_SCR); float* R1 = R0 + (size_t)T_ * 1024; float* R3 = R1 + (size_t)T_ * 1024;
  float* R2 = (float*)(ws + WS_XN);
  const float* const* in = (const float* const*)d_in;
  run(PH_PRO, PH_COUNT);

}
```

```cpp
#include <hip/hip_runtime.h>
#include <hip/hip_cooperative_groups.h>
#include <cstdio>
#include <cstdint>
namespace cg = cooperative_groups;

#define LAS __attribute__((address_space(3)))
typedef unsigned short bf16_t;
typedef short bf16x8 __attribute__((ext_vector_type(8)));
typedef float f32x4 __attribute__((ext_vector_type(4)));
typedef unsigned u32x4 __attribute__((ext_vector_type(4)));
typedef unsigned u32x2 __attribute__((ext_vector_type(2)));

constexpr int T_ = 16384, D_ = 1024, S_ = 8192;
constexpr int PAB = 2576, PC = 4112;
constexpr int LDP0 = 2560, LDP1 = 4096;
constexpr float EPS = 1e-6f;
constexpr int NTHR = 512, NWAVE = 8;
constexpr int LDS_BYTES = 151552;
constexpr int MAXROWS = 40960;

__device__ __forceinline__ float sigmoidf_(float x) { return 1.f / (1.f + __expf(-x)); }
__device__ __forceinline__ float siluf_(float x) { return x / (1.f + __expf(-x)); }
__device__ __forceinline__ float softplusf_(float x) { return x > 20.f ? x : log1pf(__expf(x)); }
__device__ __forceinline__ float gelu_tanh(float x) { return 0.5f * x * (1.f + tanhf(0.7978845608028654f * (x + 0.044715f * x * x * x))); }
__device__ __forceinline__ float wave_sum(float v) {
#pragma unroll
  for (int o = 32; o > 0; o >>= 1) v += __shfl_xor(v, o);
  return v;
}
__device__ __forceinline__ unsigned f2bf(float f) { unsigned u = __float_as_uint(f); return (u + 0x7fffu + ((u >> 16) & 1u)) >> 16; }
__device__ __forceinline__ float bf2f(unsigned h) { return __uint_as_float(h << 16); }
__device__ __forceinline__ unsigned pk2(float lo, float hi) { return f2bf(lo) | (f2bf(hi) << 16); }

namespace pg8 {
constexpr int BM = 256, BK = 64, HALF = 128, HTB = HALF * BK * 2, STAGE_BYTES = 8 * HTB, NXCD = 8, WGM = 8;
__device__ __forceinline__ int lds_byte(int r, int c) { const int st = (r >> 4) * 2 + (c >> 5), rr = r & 15, cc = c & 31, ob = rr * 64 + cc * 2; return st * 1024 + (ob ^ (((ob >> 9) & 1) << 5)); }
__device__ __forceinline__ void stage_rc(int b, int& R, int& C) { const int st = b / 1024, sb = b % 1024, swz = sb ^ (((sb >> 9) & 1) << 5); R = (st >> 1) * 16 + swz / 64; C = (st & 1) * 32 + (swz % 64) / 2; }
__device__ __forceinline__ int perm32(int rho) { const int n = rho >> 4, i = rho & 15; return 8 * (i >> 2) + 4 * n + (i & 3); }

struct Unit { int pm, pn, pc, e, slot0, cnt; };

struct StaticOrder {
  static constexpr bool GATHER = false;
  int nM, nN, nwg, G, c, K;
  __device__ void init(int M, int N, int K_, int G_, int c_) { nM = M / BM; nN = N / BM; nwg = nM * nN; G = G_; c = c_; K = K_; }
  __device__ bool next(int i, Unit& u) const {
    const long L = (long)i * G + c; if (L >= nwg) return false;
    int wgid = (int)L; { const int q = nwg / NXCD, r = nwg % NXCD, xcd = wgid % NXCD, off = wgid / NXCD; wgid = (xcd < r ? xcd * (q + 1) : r * (q + 1) + (xcd - r) * q) + off; }
    const int nig = WGM * nN, gid = wgid / nig, fm = gid * WGM, gsz = (nM - fm) < WGM ? (nM - fm) : WGM;
    u.pm = fm + ((wgid % nig) % gsz); u.pn = (wgid % nig) / gsz; u.pc = u.pn; u.e = 0; u.slot0 = 0; u.cnt = 0; return true;
  }
  __device__ __forceinline__ unsigned aoff(const Unit& u, int row, int col) const { return (unsigned)(((u.pm * BM + row) * K + col) * 2); }
};

__device__ __forceinline__ unsigned cvt_pk_bf16(float lo, float hi) { unsigned r; asm volatile("v_cvt_pk_bf16_f32 %0, %1, %2" : "=v"(r) : "v"(lo), "v"(hi)); return r; }

struct EpiBf16 {
  static constexpr bool PERM = true;
  bf16_t* O; int ldc;
  __device__ __forceinline__ void operator()(const f32x4 (&acc)[2][2][4][2], const Unit& u, int wr, int wc, int fr, int fq) const {
    const int row0 = u.pm * BM + wr * 64 + fr, col0 = u.pc * BM + wc * 32 + 8 * fq;
#pragma unroll
    for (int ai = 0; ai < 2; ++ai)
#pragma unroll
      for (int m = 0; m < 4; ++m) { bf16_t* rowp = O + (size_t)(row0 + ai * HALF + m * 16) * ldc + col0;
#pragma unroll
        for (int bj = 0; bj < 2; ++bj) { const f32x4 v0 = acc[ai][bj][m][0], v1 = acc[ai][bj][m][1];
          u32x4 w; w.x = cvt_pk_bf16(v0[0], v0[1]); w.y = cvt_pk_bf16(v0[2], v0[3]); w.z = cvt_pk_bf16(v1[0], v1[1]); w.w = cvt_pk_bf16(v1[2], v1[3]);
          *(u32x4*)(rowp + bj * HALF) = w; } }
  }
};
struct EpiResGate {
  static constexpr bool PERM = false;
  const float* res; float* out; const float* gate;
  __device__ __forceinline__ void operator()(const f32x4 (&acc)[2][2][4][2], const Unit& u, int wr, int wc, int fr, int fq) const {
    const int b = (u.pm * BM) / S_;
    const int col0 = u.pc * BM + wc * 32 + 4 * fq;
    f32x4 g[2][2];
#pragma unroll
    for (int bj = 0; bj < 2; ++bj)
#pragma unroll
      for (int n = 0; n < 2; ++n) g[bj][n] = *(const f32x4*)(gate + b * 6144 + col0 + bj * HALF + n * 16);
#pragma unroll
    for (int ai = 0; ai < 2; ++ai)
#pragma unroll
      for (int mp = 0; mp < 2; ++mp) {
        f32x4 r[2][2][2];
#pragma unroll
        for (int mm = 0; mm < 2; ++mm) { const size_t off = (size_t)(u.pm * BM + ai * HALF + wr * 64 + (2 * mp + mm) * 16 + fr) * D_ + col0;
#pragma unroll
          for (int bj = 0; bj < 2; ++bj)
#pragma unroll
            for (int n = 0; n < 2; ++n) r[mm][bj][n] = *(const f32x4*)(res + off + bj * HALF + n * 16); }
#pragma unroll
        for (int mm = 0; mm < 2; ++mm) { const size_t off = (size_t)(u.pm * BM + ai * HALF + wr * 64 + (2 * mp + mm) * 16 + fr) * D_ + col0;
#pragma unroll
          for (int bj = 0; bj < 2; ++bj)
#pragma unroll
            for (int n = 0; n < 2; ++n) *(f32x4*)(out + off + bj * HALF + n * 16) = r[mm][bj][n] + g[bj][n] * acc[ai][bj][2 * mp + mm][n]; }
        asm volatile("" ::: "memory");
      }
  }
};
struct EpiSwiglu {
  static constexpr bool PERM = true;
  bf16_t* O;
  __device__ __forceinline__ void operator()(const f32x4 (&acc)[2][2][4][2], const Unit& u, int wr, int wc, int fr, int fq) const {
    const int row0 = u.pm * BM + wr * 64 + fr, col0 = u.pc * HALF + wc * 32 + 8 * fq;
#pragma unroll
    for (int ai = 0; ai < 2; ++ai)
#pragma unroll
      for (int m = 0; m < 4; ++m) { bf16_t* rowp = O + (size_t)(row0 + ai * HALF + m * 16) * 512 + col0;
        float v[8];
#pragma unroll
        for (int n = 0; n < 2; ++n)
#pragma unroll
          for (int i = 0; i < 4; ++i) { const float g = acc[ai][0][m][n][i], up = acc[ai][1][m][n][i]; v[n * 4 + i] = g / (1.f + __expf(-g)) * up; }
        u32x4 w; w.x = cvt_pk_bf16(v[0], v[1]); w.y = cvt_pk_bf16(v[2], v[3]); w.z = cvt_pk_bf16(v[4], v[5]); w.w = cvt_pk_bf16(v[6], v[7]);
        *(u32x4*)rowp = w; }
  }
};

template <class Epi, class Sched, bool ALIGN_EPI>
__device__ __forceinline__ void gemm_phase(LAS unsigned char* lds, const bf16_t* A, const bf16_t* Bt, int K, const Sched& S, const Epi& E) {
  const int tid = threadIdx.x, wid = __builtin_amdgcn_readfirstlane(tid >> 6), lane = tid & 63, wr = wid >> 2, wc = wid & 3, fr = lane & 15, fq = lane >> 4;
  const int nt = K / BK;
  int Rr[2], Cc[2]; unsigned voffB[2];
#pragma unroll
  for (int i = 0; i < 2; ++i) { int R, C; stage_rc(tid * 16 + i * 8192, R, C); Rr[i] = R; Cc[i] = C; const int Rb = Epi::PERM ? ((R & ~31) + perm32(R & 31)) : R; voffB[i] = (unsigned)(Rb * K + C) * 2u; }
  const size_t kstep = (size_t)(BK * 2), hstep = (size_t)HALF * K * 2, tstep = 2 * hstep;
  const unsigned ldsw = (unsigned)wid * 1024u;
  const int aoff = lds_byte(wr * 64 + fr, fq * 8), boff = lds_byte(wc * 32 + fr, fq * 8);
#define PG8_SA(b, h) (((b) * 2 + (h)) * HTB)
#define PG8_SB(b, h) ((4 + (b) * 2 + (h)) * HTB)
#define PG8_STAGE(bufoff, gbase, voff) do { _Pragma("unroll") for (int _i = 0; _i < 2; ++_i) \
    __builtin_amdgcn_global_load_lds((const unsigned*)((const char*)(gbase) + (voff)[_i]), (LAS unsigned*)(lds + (bufoff) + ldsw + _i * 8192), 16, 0, 0); } while (0)
#define PG8_LDA(dst, b, h) do { _Pragma("unroll") for (int m = 0; m < 4; ++m) _Pragma("unroll") for (int k = 0; k < 2; ++k) dst[m][k] = *(const LAS bf16x8*)(lds + PG8_SA(b, h) + aoff + m * 2048 + k * 1024); } while (0)
#define PG8_LDB(dst, b, h) do { _Pragma("unroll") for (int n = 0; n < 2; ++n) _Pragma("unroll") for (int k = 0; k < 2; ++k) dst[n][k] = *(const LAS bf16x8*)(lds + PG8_SB(b, h) + boff + n * 2048 + k * 1024); } while (0)
#define PG8_MMA(ai, bj, At, Bt_) do { __builtin_amdgcn_s_setprio(1); _Pragma("unroll") for (int m = 0; m < 4; ++m) _Pragma("unroll") for (int n = 0; n < 2; ++n) _Pragma("unroll") for (int k = 0; k < 2; ++k) \
    acc[ai][bj][m][n] = __builtin_amdgcn_mfma_f32_16x16x32_bf16(Bt_[n][k], At[m][k], acc[ai][bj][m][n], 0, 0, 0); __builtin_amdgcn_s_setprio(0); } while (0)
#define PG8_WAIT_V(n) asm volatile("s_waitcnt vmcnt(" #n ")" ::: "memory")
#define PG8_WAIT_L(n) asm volatile("s_waitcnt lgkmcnt(" #n ")" ::: "memory")
#define PG8_BAR __builtin_amdgcn_s_barrier()
#define PG8_SCHED __builtin_amdgcn_sched_barrier(0)
  Unit cur, nxt; int ui = 0;
  if (!S.next(0, cur)) return;
  f32x4 acc[2][2][4][2];
#pragma unroll
  for (int a = 0; a < 2; ++a)
#pragma unroll
    for (int b = 0; b < 2; ++b)
#pragma unroll
      for (int m = 0; m < 4; ++m)
#pragma unroll
        for (int n = 0; n < 2; ++n) acc[a][b][m][n] = (f32x4){0.f, 0.f, 0.f, 0.f};
  bf16x8 At[4][2], B0[2][2], B1[2][2];
  constexpr bool GATHER = Sched::GATHER;
  unsigned cA0[2], cA1[2], nA0[2], nA1[2];
  const char* Ab = (const char*)A;
  const char* nAb = Ab;
  if constexpr (GATHER) {
#pragma unroll
    for (int i = 0; i < 2; ++i) { cA0[i] = S.aoff(cur, Rr[i], Cc[i]); cA1[i] = S.aoff(cur, HALF + Rr[i], Cc[i]); }
  } else {
#pragma unroll
    for (int i = 0; i < 2; ++i) { cA0[i] = (unsigned)(Rr[i] * K + Cc[i]) * 2u; cA1[i] = cA0[i] + (unsigned)hstep; }
    Ab = (const char*)A + (size_t)cur.pm * tstep;
  }
  const char* cB = (const char*)Bt + (size_t)cur.pn * tstep;
  PG8_STAGE(PG8_SB(0, 0), cB, voffB); PG8_STAGE(PG8_SB(0, 1), cB + hstep, voffB); PG8_STAGE(PG8_SA(0, 0), Ab, cA0); PG8_STAGE(PG8_SA(0, 1), Ab, cA1);
  if (wr == 1) PG8_BAR;
  PG8_WAIT_V(2); PG8_BAR;
  PG8_STAGE(PG8_SB(1, 0), cB + kstep, voffB); PG8_STAGE(PG8_SA(1, 0), Ab + kstep, cA0); PG8_STAGE(PG8_SB(1, 1), cB + hstep + kstep, voffB);
  PG8_WAIT_V(6); PG8_BAR;
  for (;;) {
    const bool has_next = S.next(ui + 1, nxt);
    if constexpr (GATHER) {
#pragma unroll
      for (int i = 0; i < 2; ++i) { nA0[i] = has_next ? S.aoff(nxt, Rr[i], Cc[i]) : cA0[i]; nA1[i] = has_next ? S.aoff(nxt, HALF + Rr[i], Cc[i]) : cA1[i]; }
      asm volatile("" : "+v"(nA0[0]), "+v"(nA0[1]), "+v"(nA1[0]), "+v"(nA1[1]));
    } else { nAb = has_next ? (const char*)A + (size_t)nxt.pm * tstep : Ab; }
    const char* nB = has_next ? (const char*)Bt + (size_t)nxt.pn * tstep : cB;
    for (int t = 0; t < nt; t += 2) {
      const bool last = (t == nt - 2);
      const char* a1 = Ab + (size_t)(t + 1) * kstep;
      const char* a2 = last ? nAb : Ab + (size_t)(t + 2) * kstep; const char* b2 = last ? nB : cB + (size_t)(t + 2) * kstep;
      const char* a3 = a2 + kstep; const char* b3 = b2 + kstep;
      PG8_LDB(B0, 0, 0); PG8_LDB(B1, 0, 1); PG8_SCHED; PG8_LDA(At, 0, 0); PG8_STAGE(PG8_SA(1, 1), a1, cA1);
      if constexpr (GATHER) { if (last) {
#pragma unroll
        for (int i = 0; i < 2; ++i) { cA0[i] = nA0[i]; cA1[i] = nA1[i]; } } }
      PG8_WAIT_V(8); PG8_WAIT_L(0); PG8_BAR; PG8_MMA(0, 0, At, B0); PG8_MMA(0, 1, At, B1); PG8_BAR; PG8_SCHED;
      PG8_LDA(At, 0, 1); PG8_STAGE(PG8_SB(0, 0), b2, voffB); PG8_STAGE(PG8_SB(0, 1), b2 + hstep, voffB); PG8_STAGE(PG8_SA(0, 0), a2, cA0);
      PG8_WAIT_V(8); PG8_WAIT_L(0); PG8_BAR; PG8_MMA(1, 0, At, B0); PG8_MMA(1, 1, At, B1); PG8_BAR; PG8_SCHED;
      PG8_LDB(B0, 1, 0); PG8_LDB(B1, 1, 1); PG8_SCHED; PG8_LDA(At, 1, 0); PG8_STAGE(PG8_SA(0, 1), a2, cA1);
      PG8_WAIT_V(8); PG8_WAIT_L(0); PG8_BAR; PG8_MMA(0, 0, At, B0); PG8_MMA(0, 1, At, B1); PG8_BAR; PG8_SCHED;
      PG8_LDA(At, 1, 1); PG8_STAGE(PG8_SB(1, 0), b3, voffB); PG8_STAGE(PG8_SB(1, 1), b3 + hstep, voffB); PG8_STAGE(PG8_SA(1, 0), a3, cA0);
      PG8_WAIT_V(8); PG8_WAIT_L(0); PG8_BAR; PG8_MMA(1, 0, At, B0); PG8_MMA(1, 1, At, B1); PG8_BAR; PG8_SCHED;
    }
    if constexpr (ALIGN_EPI) { if (wr == 0) PG8_BAR; }
    E(acc, cur, wr, wc, fr, fq);
    if (!has_next) break;
#pragma unroll
    for (int a = 0; a < 2; ++a)
#pragma unroll
      for (int b = 0; b < 2; ++b)
#pragma unroll
        for (int m = 0; m < 4; ++m)
#pragma unroll
          for (int n = 0; n < 2; ++n) acc[a][b][m][n] = (f32x4){0.f, 0.f, 0.f, 0.f};
    cur = nxt; cB = nB; ++ui;
    if constexpr (!GATHER) Ab = nAb;
    if constexpr (ALIGN_EPI) { if (wr == 1) PG8_BAR; }
  }
  PG8_WAIT_V(0);
  if constexpr (!ALIGN_EPI) { if (wr == 0) PG8_BAR; }
  PG8_BAR;
#undef PG8_SA
#undef PG8_SB
#undef PG8_STAGE
#undef PG8_LDA
#undef PG8_LDB
#undef PG8_MMA
#undef PG8_WAIT_V
#undef PG8_WAIT_L
#undef PG8_BAR
#undef PG8_SCHED
}
}

struct Args {
  const float* in[32];
  float* out;
  unsigned char* ws;
  int ph_lo, ph_hi;
};
constexpr size_t MiB = 1u << 20;
constexpr size_t WS_CTL = 0;
constexpr size_t WS_MOD = 64 * 1024;
constexpr size_t WS_TOK = 1 * MiB;
constexpr size_t WS_LIST = 2 * MiB;
constexpr size_t WS_SK = 4 * MiB;
constexpr size_t WS_WIN0 = 6 * MiB;
constexpr size_t WS_WOUT0 = 11 * MiB;
constexpr size_t WS_WIN1 = 13 * MiB;
constexpr size_t WS_WOUT1 = 21 * MiB;
constexpr size_t WS_W13 = 24 * MiB;
constexpr size_t WS_W2 = 88 * MiB;
constexpr size_t WS_XN = 120 * MiB;
constexpr size_t WS_Y = 152 * MiB;
constexpr size_t WS_P = 184 * MiB;
constexpr size_t WS_HMID = WS_P;
constexpr size_t WS_YB = WS_P + 40 * MiB;
constexpr size_t WS_SCR = 312 * MiB;
constexpr size_t WS_END = 504 * MiB;
constexpr size_t WS_GW = 512 * 1024;
constexpr size_t WS_HLOC = WS_SCR;
constexpr size_t WS_CP = WS_SCR + 32 * MiB;
constexpr size_t WS_DST = WS_SCR + 64 * MiB;
constexpr size_t WS_STG = WS_SCR + 96 * MiB;
constexpr size_t WS_OLG = WS_SCR + 112 * MiB;
constexpr size_t WS_QG = WS_SCR + 128 * MiB;
constexpr size_t WS_DEC = WS_SCR + 136 * MiB;
constexpr size_t WS_CAR = WS_SCR + 137 * MiB;
constexpr size_t WS_AC = WS_SCR;
constexpr size_t WS_BCT = WS_SCR + 64 * MiB;
constexpr size_t WS_QH = WS_SCR + 128 * MiB;
constexpr size_t WS_OLOC = WS_SCR + 160 * MiB;

struct Frame {
  LAS unsigned char* lds;
  int tid, lane, wave, G, bid;
  float* out; unsigned char* ws;
};

__device__ __forceinline__ void transpose_load(f32x4 (&v)[8], const float* W, int ldw, int k0, int n0, int lane) {
  const int c4 = (lane & 7) * 4, kr = lane >> 3;
#pragma unroll
  for (int i = 0; i < 8; ++i) v[i] = *(const f32x4*)(W + (size_t)(k0 + kr + 8 * i) * ldw + n0 + c4);
}
__device__ __forceinline__ void transpose_finish(const f32x4 (&v)[8], int K, bf16_t* WT, int k0, int row0, LAS float* scr, int lane) {
  { const int c4 = (lane & 7) * 4, kr = lane >> 3;
#pragma unroll
    for (int i = 0; i < 8; ++i) { LAS float* d = scr + (kr + 8 * i) * 33 + c4; d[0] = v[i][0]; d[1] = v[i][1]; d[2] = v[i][2]; d[3] = v[i][3]; } }
  asm volatile("s_waitcnt lgkmcnt(0)" ::: "memory");
  const int c = lane & 7;
#pragma unroll
  for (int j = 0; j < 4; ++j) { const int n = (lane >> 3) + 8 * j; const LAS float* s = scr + (8 * c) * 33 + n;
    u32x4 o; o.x = pk2(s[0 * 33], s[1 * 33]); o.y = pk2(s[2 * 33], s[3 * 33]); o.z = pk2(s[4 * 33], s[5 * 33]); o.w = pk2(s[6 * 33], s[7 * 33]);
    *(u32x4*)(WT + (size_t)(row0 + n) * K + k0 + 8 * c) = o; }
  asm volatile("s_waitcnt lgkmcnt(0)" ::: "memory");
}
struct TItem { const float* W; bf16_t* WT; int ldw, K, k0, n0, row0; };
__device__ __forceinline__ TItem moe_item(const Args& A, unsigned char* ws, int layer, int it) {
  const int e = it / 768, r = it % 768, le = layer * 32 + e; TItem t;
  if (r < 512) {
    const int which = r >> 8, rr = r & 255, kb = rr / 16, nb = rr % 16, n0 = nb * 32;
    t.W = (which ? A.in[29] : A.in[28]) + (size_t)le * 1024 * 512; t.ldw = 512; t.K = 1024; t.WT = (bf16_t*)(ws + WS_W13) + (size_t)e * 1024 * 1024;
    t.k0 = kb * 64; t.n0 = n0; t.row0 = (n0 >> 7) * 256 + (n0 & 127) + which * 128;
  } else {
    const int rr = r - 512, kb = rr / 32, nb = rr % 32;
    t.W = A.in[30] + (size_t)le * 512 * 1024; t.ldw = 1024; t.K = 512; t.WT = (bf16_t*)(ws + WS_W2) + (size_t)e * 1024 * 512; t.k0 = kb * 64; t.n0 = nb * 32; t.row0 = nb * 32;
  }
  return t;
}
__device__ __forceinline__ void convert_moe(Frame& F, const Args& A, int layer, int b0, int nb) {
  LAS float* scr = (LAS float*)(F.lds + F.wave * 16384);
  const int gw = (F.bid - b0) * NWAVE + F.wave, NGW = nb * NWAVE;
  f32x4 va[8], vb[8];
  int it = gw;
  TItem cur = moe_item(A, F.ws, layer, it < 32 * 768 ? it : 0);
  if (it < 32 * 768) transpose_load(va, cur.W, cur.ldw, cur.k0, cur.n0, F.lane);
#pragma unroll 1
  for (; it < 32 * 768; it += 2 * NGW) {
    const int i1 = it + NGW, i2 = it + 2 * NGW;
    TItem nx = moe_item(A, F.ws, layer, i1 < 32 * 768 ? i1 : 0);
    if (i1 < 32 * 768) transpose_load(vb, nx.W, nx.ldw, nx.k0, nx.n0, F.lane);
    transpose_finish(va, cur.K, cur.WT, cur.k0, cur.row0, scr, F.lane);
    if (i1 < 32 * 768) {
      cur = moe_item(A, F.ws, layer, i2 < 32 * 768 ? i2 : 0);
      if (i2 < 32 * 768) transpose_load(va, cur.W, cur.ldw, cur.k0, cur.n0, F.lane);
      transpose_finish(vb, nx.K, nx.WT, nx.k0, nx.row0, scr, F.lane);
    }
  }
}
__device__ __forceinline__ void ph_prologue(Frame& F, const Args& A) {
  LAS float* scr = (LAS float*)(F.lds + F.wave * 16384);
  const int gw = F.bid * NWAVE + F.wave, NGW = F.G * NWAVE;
  if (F.bid == 0 && F.tid < 64) ((int*)(F.ws + WS_CTL))[F.tid] = 0;
  constexpr int I_IN0 = 16 * 80, I_OUT = 16 * 32, I_IN1 = 16 * 128;
  constexpr int NIT = I_IN0 + I_OUT + I_IN1 + I_OUT;
  for (int it = gw; it < NIT; it += NGW) {
    int r = it;
    if (r < I_IN0) { const int kb = r / 80, nb = r % 80; { f32x4 v[8]; transpose_load(v, A.in[6], PAB, kb * 64, nb * 32, F.lane); transpose_finish(v, 1024, (bf16_t*)(F.ws + WS_WIN0), kb * 64, nb * 32, scr, F.lane); } continue; } r -= I_IN0;
    if (r < I_OUT) { const int kb = r / 32, nb = r % 32; { f32x4 v[8]; transpose_load(v, A.in[17], 1024, kb * 64, nb * 32, F.lane); transpose_finish(v, 1024, (bf16_t*)(F.ws + WS_WOUT0), kb * 64, nb * 32, scr, F.lane); } continue; } r -= I_OUT;
    if (r < I_IN1) { const int kb = r / 128, nb = r % 128; { f32x4 v[8]; transpose_load(v, A.in[18], PC, kb * 64, nb * 32, F.lane); transpose_finish(v, 1024, (bf16_t*)(F.ws + WS_WIN1), kb * 64, nb * 32, scr, F.lane); } continue; } r -= I_IN1;
    { const int kb = r / 32, nb = r % 32; f32x4 v[8]; transpose_load(v, A.in[23], 1024, kb * 64, nb * 32, F.lane); transpose_finish(v, 1024, (bf16_t*)(F.ws + WS_WOUT1), kb * 64, nb * 32, scr, F.lane); }
  }
  {
    bf16_t* WAT = (bf16_t*)(F.ws + WS_GW);
    for (int idx = F.bid * NTHR + F.tid; idx < 65536; idx += F.G * NTHR) { const int mtx = idx >> 15, h = (idx >> 12) & 7, j = (idx >> 6) & 63, i = idx & 63;
      WAT[idx] = (bf16_t)f2bf((mtx ? A.in[11] : A.in[9])[h * 4096 + i * 64 + j]); }
  }
  const float* c = A.in[1]; const float* w_ada = A.in[4]; const float* b_ada = A.in[5]; float* mod = (float*)(F.ws + WS_MOD);
  { LAS float* red = (LAS float*)(F.lds + 131072);
    for (int un = F.bid; un < 384; un += F.G) {
      const int l = un / 192, n0 = (un % 192) * 32, kg = F.lane >> 3, cq = F.lane & 7;
      f32x4 a0 = {0.f, 0.f, 0.f, 0.f}, a1 = {0.f, 0.f, 0.f, 0.f};
      const float* w = w_ada + (size_t)l * 1024 * 6144 + n0 + cq * 4;
      const int kbase = F.wave * 128 + kg * 16;
#pragma unroll
      for (int k = 0; k < 16; ++k) { const f32x4 wv = *(const f32x4*)(w + (size_t)(kbase + k) * 6144); const float c0 = siluf_(c[kbase + k]), c1 = siluf_(c[1024 + kbase + k]); a0 += wv * c0; a1 += wv * c1; }
#pragma unroll
      for (int o = 8; o < 64; o <<= 1)
#pragma unroll
        for (int i = 0; i < 4; ++i) { a0[i] += __shfl_xor(a0[i], o); a1[i] += __shfl_xor(a1[i], o); }
      __syncthreads();
      if (kg == 0) { *(LAS f32x4*)(red + F.wave * 64 + cq * 4) = a0; *(LAS f32x4*)(red + F.wave * 64 + 32 + cq * 4) = a1; }
      __syncthreads();
      if (F.tid < 64) { float v = 0.f;
#pragma unroll
        for (int wv = 0; wv < 8; ++wv) v += red[wv * 64 + F.tid];
        const int bsel = F.tid >> 5, col = F.tid & 31;
        mod[(l * 2 + bsel) * 6144 + n0 + col] = v + b_ada[l * 6144 + n0 + col]; }
    }
  }
}

template <int MODE>
__device__ __forceinline__ void ph_norm(Frame& F, const Args& A, int l) {
  constexpr bool COMBINE = (MODE == 1 || MODE == 3);
  constexpr int NS = (MODE == 2) ? 36 : (MODE == 3 ? 0 : 16);
  constexpr int NSP = (MODE == 2) ? 36 : 20;
  LAS float* wl = (LAS float*)F.lds;
  LAS int* tb = (LAS int*)(F.lds + 147456);
  LAS int* lcnt = (LAS int*)(F.lds + 147456 + 256);
  LAS int* rinfo = (LAS int*)(F.lds + 147456 + 1024);
  if (MODE == 2 && F.tid < 64) lcnt[F.tid] = 0;
  const float* mod = (const float*)(F.ws + WS_MOD);
  if (NS > 0) {
#pragma unroll 1
    for (int k = F.tid; k < 1024; k += NTHR) {
      const int rho = ((k >> 2) & 63) + 64 * (((k >> 8) << 2) + (k & 3));
      LAS float* dst = wl + rho * NSP;
      if (MODE == 2) {
        *(LAS f32x4*)dst = *(const f32x4*)(A.in[24] + (size_t)l * 4096 + k * 4);
        const float* src = A.in[26] + (size_t)l * 32768 + k * 32;
#pragma unroll
        for (int i = 0; i < 8; ++i) *(LAS f32x4*)(dst + 4 + 4 * i) = *(const f32x4*)(src + 4 * i);
      } else {
        const float* src = MODE == 0 ? A.in[6] + (size_t)k * PAB + 2560 : A.in[18] + (size_t)k * PC + 4096;
#pragma unroll
        for (int i = 0; i < 4; ++i) *(LAS f32x4*)(dst + 4 * i) = *(const f32x4*)(src + 4 * i);
      }
    }
  }
  const int lc = (MODE == 1) ? 0 : 1;
  if (COMBINE) { if (F.tid == 0) { const int* cnt = (const int*)(F.ws + WS_CTL) + lc * 32; int acc = 0;
#pragma unroll 1
    for (int e = 0; e < 32; ++e) { tb[e] = acc; acc += (cnt[e] + 255) >> 8; } } }
  __syncthreads();
  const float* hin = (MODE == 0) ? A.in[0] : F.out;
  const float* gvec = (MODE == 3) ? A.in[31] : (MODE == 2 ? A.in[3] + l * D_ : A.in[2] + l * D_);
  const float* modl = mod + l * 2 * 6144;
  const int shp = (MODE == 2) ? 3 : 0, scp = (MODE == 2) ? 4 : 1;
  const int* tok_e = (const int*)(F.ws + WS_TOK); const int* tok_s = tok_e + 2 * T_; const float* tok_w = (const float*)(tok_s + 2 * T_);
  const bf16_t* yb = (const bf16_t*)(F.ws + WS_YB);
  bf16_t* xn = (bf16_t*)(F.ws + WS_XN);
  const int gw = F.bid * NWAVE + F.wave, NGW = F.G * NWAVE, lane = F.lane;
  constexpr int RPW = 2;
  for (int it = gw; it < T_ / RPW; it += NGW) {
    float u[RPW][16];
#pragma unroll
    for (int r = 0; r < RPW; ++r) {
      const int row = it * RPW + r, b = row / S_;
      const float* hr = hin + (size_t)row * D_;
      float v[16];
#pragma unroll
      for (int j = 0; j < 4; ++j) { const f32x4 x = *(const f32x4*)(hr + lane * 4 + 256 * j); v[4*j] = x[0]; v[4*j+1] = x[1]; v[4*j+2] = x[2]; v[4*j+3] = x[3]; }
      if (COMBINE) {
        const int e0 = tok_e[row * 2], e1 = tok_e[row * 2 + 1];
        const int r0 = tb[e0] * 256 + tok_s[row * 2], r1 = tb[e1] * 256 + tok_s[row * 2 + 1];
        const float w0 = tok_w[row * 2], w1 = tok_w[row * 2 + 1];
        const float* g2 = mod + (lc * 2 + b) * 6144 + 5 * 1024;
#pragma unroll
        for (int j = 0; j < 4; ++j) {
          const u32x2 y0 = *(const u32x2*)(yb + (size_t)r0 * D_ + lane * 4 + 256 * j), y1 = *(const u32x2*)(yb + (size_t)r1 * D_ + lane * 4 + 256 * j);
          const f32x4 g = *(const f32x4*)(g2 + lane * 4 + 256 * j);
          v[4*j]   += g[0] * (w0 * bf2f(y0.x & 0xffffu) + w1 * bf2f(y1.x & 0xffffu));
          v[4*j+1] += g[1] * (w0 * bf2f(y0.x >> 16) + w1 * bf2f(y1.x >> 16));
          v[4*j+2] += g[2] * (w0 * bf2f(y0.y & 0xffffu) + w1 * bf2f(y1.y & 0xffffu));
          v[4*j+3] += g[3] * (w0 * bf2f(y0.y >> 16) + w1 * bf2f(y1.y >> 16));
        }
        if (MODE == 1) {
#pragma unroll
          for (int j = 0; j < 4; ++j) *(f32x4*)(F.out + (size_t)row * D_ + lane * 4 + 256 * j) = (f32x4){v[4*j], v[4*j+1], v[4*j+2], v[4*j+3]};
        }
      }
      float ss = 0.f;
#pragma unroll
      for (int i = 0; i < 16; ++i) ss += v[i] * v[i];
      ss = wave_sum(ss);
      const float rstd = rsqrtf(ss * (1.f / D_) + EPS);
#pragma unroll
      for (int j = 0; j < 4; ++j) {
        const f32x4 g = *(const f32x4*)(gvec + lane * 4 + 256 * j);
        f32x4 y = {v[4*j] * rstd * g[0], v[4*j+1] * rstd * g[1], v[4*j+2] * rstd * g[2], v[4*j+3] * rstd * g[3]};
        if (MODE != 3) { const f32x4 sc = *(const f32x4*)(modl + b * 6144 + scp * 1024 + lane * 4 + 256 * j), sh = *(const f32x4*)(modl + b * 6144 + shp * 1024 + lane * 4 + 256 * j); y = y * (1.f + sc) + sh; }
        u[r][4*j] = y[0]; u[r][4*j+1] = y[1]; u[r][4*j+2] = y[2]; u[r][4*j+3] = y[3];
        if (MODE == 3) *(f32x4*)(F.out + (size_t)row * D_ + lane * 4 + 256 * j) = y;
        else { u32x2 p; p.x = pk2(y[0], y[1]); p.y = pk2(y[2], y[3]); *(u32x2*)(xn + (size_t)row * D_ + lane * 4 + 256 * j) = p; }
      }
    }
    if (MODE == 0 || MODE == 1) {
#pragma unroll 1
      for (int cgp = 0; cgp < 4; ++cgp) {
        f32x4 a[RPW];
#pragma unroll
        for (int r = 0; r < RPW; ++r) a[r] = (f32x4){0.f, 0.f, 0.f, 0.f};
#pragma unroll
        for (int kk = 0; kk < 16; ++kk) {
          const f32x4 w = *(const LAS f32x4*)(wl + (lane + 64 * kk) * NSP + cgp * 4);
#pragma unroll
          for (int r = 0; r < RPW; ++r) a[r] += w * u[r][kk];
        }
#pragma unroll
        for (int r = 0; r < RPW; ++r)
#pragma unroll
          for (int i = 0; i < 4; ++i) a[r][i] = wave_sum(a[r][i]);
        if (lane < RPW) { const f32x4 v = lane == 0 ? a[0] : a[1]; *(f32x4*)((float*)(F.ws + WS_SK) + (size_t)(it * RPW + lane) * 16 + cgp * 4) = v; }
      }
    }
    if (MODE == 2) {
      f32x4 ag[RPW];
#pragma unroll
      for (int r = 0; r < RPW; ++r) ag[r] = (f32x4){0.f, 0.f, 0.f, 0.f};
#pragma unroll
      for (int kk = 0; kk < 16; ++kk) {
        const f32x4 w = *(const LAS f32x4*)(wl + (lane + 64 * kk) * NSP);
#pragma unroll
        for (int r = 0; r < RPW; ++r) ag[r] += w * u[r][kk];
      }
      const float* bg = A.in[25] + l * 4; const float* br = A.in[27] + l * 32;
#pragma unroll
      for (int r = 0; r < RPW; ++r) {
        const int row = it * RPW + r;
        float g4[4];
#pragma unroll
        for (int i = 0; i < 4; ++i) g4[i] = wave_sum(ag[r][i]) + bg[i];
        int gi = 0; float gm = g4[0];
#pragma unroll
        for (int i = 1; i < 4; ++i) if (g4[i] > gm) { gm = g4[i]; gi = i; }
        float se = 0.f;
#pragma unroll
        for (int i = 0; i < 4; ++i) se += __expf(g4[i] - gm);
        const float pg = 1.f / se;
        f32x4 e0v = {0.f, 0.f, 0.f, 0.f}, e1v = {0.f, 0.f, 0.f, 0.f};
#pragma unroll
        for (int kk = 0; kk < 16; ++kk) {
          const LAS float* wp = wl + (lane + 64 * kk) * NSP + 4 + gi * 8;
          e0v += *(const LAS f32x4*)wp * u[r][kk]; e1v += *(const LAS f32x4*)(wp + 4) * u[r][kk];
        }
        float le[8];
#pragma unroll
        for (int i = 0; i < 4; ++i) { le[i] = wave_sum(e0v[i]) + br[gi * 8 + i]; le[4 + i] = wave_sum(e1v[i]) + br[gi * 8 + 4 + i]; }
        float m0 = -3.4e38f, m1 = -3.4e38f; int e0 = 0, e1 = 0;
#pragma unroll
        for (int i = 0; i < 8; ++i) { const float x = le[i];
          if (x > m0) { m1 = m0; e1 = e0; m0 = x; e0 = i; } else if (x > m1) { m1 = x; e1 = i; } }
        const float p1 = __expf(m1 - m0), w0 = pg / (1.f + p1), w1 = pg * p1 / (1.f + p1);
        const int E0 = gi * 8 + e0, E1 = gi * 8 + e1;
        if (lane == 0) {
          const int ls0 = __hip_atomic_fetch_add(&lcnt[E0], 1, __ATOMIC_RELAXED, __HIP_MEMORY_SCOPE_WORKGROUP), ls1 = __hip_atomic_fetch_add(&lcnt[E1], 1, __ATOMIC_RELAXED, __HIP_MEMORY_SCOPE_WORKGROUP);
          const int ri = __hip_atomic_fetch_add(&lcnt[32], 1, __ATOMIC_RELAXED, __HIP_MEMORY_SCOPE_WORKGROUP);
          rinfo[ri * 4] = row; rinfo[ri * 4 + 1] = E0 | (E1 << 8); rinfo[ri * 4 + 2] = ls0; rinfo[ri * 4 + 3] = ls1;
          float* tw = (float*)(F.ws + WS_TOK) + 4 * T_; tw[row * 2] = w0; tw[row * 2 + 1] = w1;
        }
      }
    }
  }
  if (MODE == 2) {
    __syncthreads();
    if (F.tid < 32) { const int c = lcnt[F.tid]; lcnt[64 + F.tid] = c ? atomicAdd((int*)(F.ws + WS_CTL) + l * 32 + F.tid, c) : 0; }
    __syncthreads();
    const int nr = lcnt[32];
    int* list = (int*)(F.ws + WS_LIST); int* te = (int*)(F.ws + WS_TOK); int* ts = te + 2 * T_;
    for (int r = F.tid; r < nr; r += NTHR) {
      const int row = rinfo[r * 4], ee = rinfo[r * 4 + 1], E0 = ee & 255, E1 = ee >> 8;
      const int s0 = lcnt[64 + E0] + rinfo[r * 4 + 2], s1 = lcnt[64 + E1] + rinfo[r * 4 + 3];
      list[E0 * T_ + s0] = row; list[E1 * T_ + s1] = row;
      te[row * 2] = E0; te[row * 2 + 1] = E1; ts[row * 2] = s0; ts[row * 2 + 1] = s1;
    }
  }
}

template <bool GATHER_> struct MoeSched {
  static constexpr bool GATHER = GATHER_;
  const LAS int* tb; const LAS int* cn; const int* list; int G, c, K, ntot;
  __device__ bool next(int i, pg8::Unit& u) const {
    const int L = i * G + c; if (L >= ntot * 4) return false;
    const int rt = L >> 2, pc = L & 3; const int e = tb[80 + rt];
    u.pm = rt; u.pc = pc; u.pn = e * 4 + pc; u.e = e; u.slot0 = (rt - tb[e]) * 256; u.cnt = cn[e]; return true;
  }
  __device__ __forceinline__ unsigned aoff(const pg8::Unit& u, int row, int col) const {
    if (GATHER) { const int s = u.slot0 + row; const int tok = s < u.cnt ? list[u.e * T_ + s] : 0; return (unsigned)((tok * K + col) * 2); }
    return (unsigned)(((u.pm * 256 + row) * K + col) * 2);
  }
};
__device__ __forceinline__ void moe_tables(Frame& F, int l, LAS int* tb, LAS int* cn) {
  if (F.tid == 0) { const int* cnt = (const int*)(F.ws + WS_CTL) + l * 32; int acc = 0;
#pragma unroll 1
    for (int e = 0; e < 32; ++e) { const int c = cnt[e]; tb[e] = acc; cn[e] = c; const int nt = (c + 255) >> 8;
#pragma unroll 1
      for (int j = 0; j < nt; ++j) tb[80 + acc + j] = e;
      acc += nt; }
    tb[32] = acc; }
  __syncthreads();
}


__device__ __forceinline__ f32x4 mfma16(bf16x8 a, bf16x8 b, f32x4 c) { return __builtin_amdgcn_mfma_f32_16x16x32_bf16(a, b, c, 0, 0, 0); }
template <int K>
__device__ __forceinline__ f32x4 mma_tile(const LAS bf16_t* A, int lda, const LAS bf16_t* Bt, int ldb, int lane, f32x4 acc) {
  const int r = lane & 15, q = lane >> 4;
#pragma unroll
  for (int kb = 0; kb < K / 32; ++kb) {
    const bf16x8 a = *(const LAS bf16x8*)(A + r * lda + kb * 32 + q * 8);
    const bf16x8 b = *(const LAS bf16x8*)(Bt + r * ldb + kb * 32 + q * 8);
    acc = mfma16(a, b, acc);
  }
  return acc;
}
__device__ __forceinline__ u32x2 pack4(f32x4 v) { u32x2 p; p.x = pk2(v[0], v[1]); p.y = pk2(v[2], v[3]); return p; }
__device__ __forceinline__ f32x4 unpack4(u32x2 p) { return (f32x4){bf2f(p.x & 0xffffu), bf2f(p.x >> 16), bf2f(p.y & 0xffffu), bf2f(p.y >> 16)}; }

__device__ __forceinline__ void ph_dn1(Frame& F, const Args& A) {
  LAS bf16_t* Kt = (LAS bf16_t*)(F.lds + 0);
  LAS bf16_t* Qt = (LAS bf16_t*)(F.lds + 17408);
  LAS bf16_t* ATT = (LAS bf16_t*)(F.lds + 34816);
  LAS bf16_t* KTt = (LAS bf16_t*)(F.lds + 44032);
  LAS float* Lm = (LAS float*)(F.lds + 62464);
  LAS bf16_t* Vs = (LAS bf16_t*)(F.lds + 79872);
  LAS bf16_t* UWt = (LAS bf16_t*)(F.lds + 97280);
  LAS float* CW = (LAS float*)(F.lds + 134144);
  LAS float* SC = (LAS float*)(F.lds + 140288);
  LAS bf16_t* DI = (LAS bf16_t*)(F.lds + 141312);
  const bf16_t* P = (const bf16_t*)(F.ws + WS_P); const float* SK = (const float*)(F.ws + WS_SK);
  const float* conv_w = A.in[19];
  const int wave = F.wave;
  int hprev = -1;
  for (int u = F.bid; u < 2048; u += F.G) {
    int tid = F.tid; asm volatile("" : "+v"(tid));
    const int lane = tid & 63;
    const int h = u & 7, c = (u >> 3) & 127, b = u >> 10;
    const int t0 = b * S_ + c * 64;
    if (h != hprev) {
      for (int i = tid; i < 1536; i += NTHR) { const int x = i >> 9, j = (i >> 7) & 3, ch = i & 127; CW[i] = conv_w[j * 3072 + x * 1024 + h * 128 + ch]; }
      hprev = h;
    }
    if (tid < 64) {
      const float bl = SK[(size_t)(t0 + tid) * 16 + h], al = SK[(size_t)(t0 + tid) * 16 + 8 + h];
      float g = -__expf(A.in[20][h]) * softplusf_(al + A.in[21][h]);
#pragma unroll
      for (int d = 1; d < 64; d <<= 1) { const float o = __shfl_up(g, d); if (lane >= d) g += o; }
      SC[tid] = sigmoidf_(bl); SC[64 + tid] = g;
    }
    {
      const int tok = tid >> 3, part = tid & 7, tl = c * 64 + tok;
      float vm[4]; const bf16_t* src[4];
#pragma unroll
      for (int j = 0; j < 4; ++j) { const bool valid = (tl - 3 + j) >= 0; vm[j] = valid ? 1.f : 0.f; src[j] = P + (size_t)(t0 + tok - (valid ? 3 - j : 0)) * LDP1 + h * 128 + part * 16; }
      u32x4 raw[4][2];
#pragma unroll
      for (int j = 0; j < 4; ++j) { raw[j][0] = *(const u32x4*)(src[j]); raw[j][1] = *(const u32x4*)(src[j] + 8); }
      __syncthreads();
#pragma unroll
      for (int x = 0; x < 3; ++x) {
        float acc[16];
#pragma unroll
        for (int i = 0; i < 16; ++i) acc[i] = 0.f;
        u32x4 cur[4][2];
#pragma unroll
        for (int j = 0; j < 4; ++j) { cur[j][0] = raw[j][0]; cur[j][1] = raw[j][1]; }
        if (x < 2) {
#pragma unroll
          for (int j = 0; j < 4; ++j) { raw[j][0] = *(const u32x4*)(src[j] + (x + 1) * 1024); raw[j][1] = *(const u32x4*)(src[j] + (x + 1) * 1024 + 8); }
        }
#pragma unroll
        for (int j = 0; j < 4; ++j) {
          const LAS float* w = CW + (x * 4 + j) * 128 + part * 16;
          const u32x4 v0 = cur[j][0], v1 = cur[j][1];
          const unsigned vv[8] = {v0.x, v0.y, v0.z, v0.w, v1.x, v1.y, v1.z, v1.w};
#pragma unroll
          for (int i = 0; i < 8; ++i) { acc[2*i] += w[2*i] * vm[j] * bf2f(vv[i] & 0xffffu); acc[2*i+1] += w[2*i+1] * vm[j] * bf2f(vv[i] >> 16); }
        }
        float s2 = 0.f;
#pragma unroll
        for (int i = 0; i < 16; ++i) { acc[i] = siluf_(acc[i]); s2 += acc[i] * acc[i]; }
        if (x < 2) {
          s2 += __shfl_xor(s2, 1); s2 += __shfl_xor(s2, 2); s2 += __shfl_xor(s2, 4);
          float sc = rsqrtf(s2 + EPS); if (x == 0) sc *= 0.08838834764831845f;
          LAS bf16_t* dst = (x == 0 ? Qt : Kt) + tok * 136 + part * 16;
          u32x4 o0, o1;
          o0.x = pk2(acc[0] * sc, acc[1] * sc); o0.y = pk2(acc[2] * sc, acc[3] * sc); o0.z = pk2(acc[4] * sc, acc[5] * sc); o0.w = pk2(acc[6] * sc, acc[7] * sc);
          o1.x = pk2(acc[8] * sc, acc[9] * sc); o1.y = pk2(acc[10] * sc, acc[11] * sc); o1.z = pk2(acc[12] * sc, acc[13] * sc); o1.w = pk2(acc[14] * sc, acc[15] * sc);
          *(LAS u32x4*)dst = o0; *(LAS u32x4*)(dst + 8) = o1;
        } else {
          LAS bf16_t* dst = Vs + tok * 136 + part * 16;
          u32x4 o0, o1;
          o0.x = pk2(acc[0], acc[1]); o0.y = pk2(acc[2], acc[3]); o0.z = pk2(acc[4], acc[5]); o0.w = pk2(acc[6], acc[7]);
          o1.x = pk2(acc[8], acc[9]); o1.y = pk2(acc[10], acc[11]); o1.z = pk2(acc[12], acc[13]); o1.w = pk2(acc[14], acc[15]);
          *(LAS u32x4*)dst = o0; *(LAS u32x4*)(dst + 8) = o1;
        }
      }
    }
    __syncthreads();
    {
      const int q = lane >> 4, cc = lane & 15;
#pragma unroll 1
      for (int m = 0; m < 4; ++m) {
        const int id = wave * 4 + m, mat = id >> 4, ti = (id >> 2) & 3, tj = id & 3;
        f32x4 acc = {0.f, 0.f, 0.f, 0.f};
        if (tj <= ti) acc = mma_tile<128>((mat == 0 ? Kt : Qt) + ti * 16 * 136, 136, Kt + tj * 16 * 136, 136, lane, acc);
        const int j = tj * 16 + cc; const float gj = SC[64 + j];
#pragma unroll
        for (int r = 0; r < 4; ++r) {
          const int i = ti * 16 + 4 * q + r; const float d = __expf(SC[64 + i] - gj);
          if (mat == 0) Lm[i * 68 + j] = (i > j) ? SC[i] * acc[r] * d : 0.f;
          else ATT[i * 72 + j] = (bf16_t)f2bf((i >= j) ? acc[r] * d : 0.f);
        }
      }
    }
    __syncthreads();
    if (wave == 0) {
      const int blk = lane >> 4, col = lane & 15;
      const LAS float* Lb = Lm + (16 * blk) * 68 + 16 * blk;
      float d[16];
#pragma unroll
      for (int i = 0; i < 16; ++i) {
        float a = (i == col) ? 1.f : 0.f;
#pragma unroll
        for (int j4 = 0; j4 < (i + 3) / 4; ++j4) {
          const f32x4 l = *(const LAS f32x4*)(Lb + i * 68 + 4 * j4);
#pragma unroll
          for (int jj = 0; jj < 4; ++jj) if (4 * j4 + jj < i) a -= l[jj] * d[4 * j4 + jj];
        }
        d[i] = a;
        DI[blk * 256 + i * 16 + col] = (bf16_t)f2bf(a);
      }
    } else {
      const float gl = SC[64 + 63];
      for (int e = tid - 64; e < 8192; e += 448) { const int tok = e >> 7, dk = e & 127; KTt[dk * 72 + tok] = (bf16_t)f2bf(bf2f(Kt[tok * 136 + dk]) * __expf(gl - SC[64 + tok])); }
    }
    __syncthreads();
    {
      typedef short s16x4 __attribute__((ext_vector_type(4)));
      const int q = lane >> 4, cc = lane & 15;
      s16x4 lneg[4][3], dfr[4];
#pragma unroll
      for (int I = 0; I < 4; ++I) {
        dfr[I] = __builtin_bit_cast(s16x4, *(const LAS u32x2*)(DI + I * 256 + cc * 16 + 4 * q));
#pragma unroll
        for (int J = 0; J < 3; ++J) if (J < I) { const f32x4 l = *(const LAS f32x4*)(Lm + (16 * I + cc) * 68 + 16 * J + 4 * q); lneg[I][J] = __builtin_bit_cast(s16x4, pack4(-l)); }
      }
#pragma unroll
      for (int t = 0; t < 2; ++t) {
        const int ct = 2 * wave + t, n = ct * 16 + cc;
        s16x4 xb[4];
#pragma unroll
        for (int I = 0; I < 4; ++I) {
          f32x4 acc;
#pragma unroll
          for (int i = 0; i < 4; ++i) { const int row = 16 * I + 4 * q + i;
            acc[i] = (ct < 8) ? SC[row] * bf2f(Vs[row * 136 + n]) : SC[row] * __expf(SC[64 + row]) * bf2f(Kt[row * 136 + (n - 128)]); }
#pragma unroll
          for (int J = 0; J < 3; ++J) if (J < I) acc = __builtin_amdgcn_mfma_f32_16x16x16bf16_1k(lneg[I][J], xb[J], acc, 0, 0, 0);
          const f32x4 x = __builtin_amdgcn_mfma_f32_16x16x16bf16_1k(dfr[I], __builtin_bit_cast(s16x4, pack4(acc)), (f32x4){0.f, 0.f, 0.f, 0.f}, 0, 0, 0);
          const u32x2 xp = pack4(x);
          xb[I] = __builtin_bit_cast(s16x4, xp);
          *(LAS u32x2*)(UWt + n * 72 + 16 * I + 4 * q) = xp;
        }
      }
    }
    __syncthreads();
    {
      const int q = lane >> 4, cc = lane & 15;
      bf16_t* OL = (bf16_t*)(F.ws + WS_OLOC); bf16_t* QH = (bf16_t*)(F.ws + WS_QH) + (size_t)u * 64 * 128;
      bf16_t* BCT = (bf16_t*)(F.ws + WS_BCT) + (size_t)u * 128 * 128; bf16_t* AC = (bf16_t*)(F.ws + WS_AC) + (size_t)u * 128 * 128;
      const float egl = __expf(SC[64 + 63]);
#pragma unroll 1
      for (int m = 0; m < 24; ++m) {
        const int id = wave + 8 * m;
        f32x4 acc = {0.f, 0.f, 0.f, 0.f};
        if (id < 32) {
          const int tdv = id >> 2, tt = id & 3;
          acc = mma_tile<64>(UWt + tdv * 16 * 72, 72, ATT + tt * 16 * 72, 72, lane, acc);
          *(u32x2*)(OL + (size_t)(t0 + tt * 16 + cc) * D_ + h * 128 + tdv * 16 + 4 * q) = pack4(acc);
        } else if (id < 64) {
          const int tdk = (id - 32) >> 2, tt = id & 3, tok = tt * 16 + cc;
          acc = mma_tile<64>(UWt + (128 + tdk * 16) * 72, 72, ATT + tt * 16 * 72, 72, lane, acc);
          const u32x2 qv = *(const LAS u32x2*)(Qt + tok * 136 + tdk * 16 + 4 * q);
          const float eg = __expf(SC[64 + tok]);
          *(u32x2*)(QH + tok * 128 + tdk * 16 + 4 * q) = pack4(unpack4(qv) * eg - acc);
        } else if (id < 128) {
          const int tdk = (id - 64) >> 3, tdv = id & 7;
          acc = mma_tile<64>(KTt + tdk * 16 * 72, 72, UWt + tdv * 16 * 72, 72, lane, acc);
          *(u32x2*)(BCT + (tdv * 16 + cc) * 128 + tdk * 16 + 4 * q) = pack4(acc);
        } else {
          const int tn = (id - 128) >> 3, tm = id & 7, mm = tm * 16 + cc;
          acc = mma_tile<64>(UWt + (128 + tn * 16) * 72, 72, KTt + tm * 16 * 72, 72, lane, acc);
          f32x4 v;
#pragma unroll
          for (int r = 0; r < 4; ++r) v[r] = ((tn * 16 + 4 * q + r) == mm ? egl : 0.f) - acc[r];
          *(u32x2*)(AC + mm * 128 + 32 * (tn >> 1) + 8 * q + 4 * (tn & 1)) = pack4(v);
        }
      }
    }
    __syncthreads();
  }
}

__device__ __forceinline__ void ph_dn2(Frame& F, const Args& A) {
  if (F.bid >= 64) { convert_moe(F, A, 1, 64, F.G - 64); return; }
  const int xcd = F.bid & 7, jj = F.bid >> 3, bh = xcd * 2 + (jj >> 2), quarter = jj & 3, b = bh >> 3, h = bh & 7;
  const int lane = F.lane, wave = F.wave, q = lane >> 4, cc = lane & 15;
  const bf16_t* AC = (const bf16_t*)(F.ws + WS_AC); bf16_t* BCT = (bf16_t*)(F.ws + WS_BCT);
  const size_t u0 = (size_t)(b * 128) * 8 + h;
  if (wave >= 4) {
    const int lw = wave - 4;
#define DN2_DMA(step) do { const bf16_t* src = AC + (u0 + 8 * (size_t)(step)) * 16384; const unsigned sb = (unsigned)((step) & 3) * 32768u; \
      _Pragma("unroll") for (int m = 0; m < 8; ++m) { const int ch = lw * 64 + lane + 256 * m, row = ch >> 4, c16 = ch & 15; \
        __builtin_amdgcn_global_load_lds((const unsigned*)(src + row * 128 + ((c16 ^ (row & 15)) << 3)), (LAS unsigned*)(F.lds + sb + lw * 1024 + m * 4096), 16, 0, 0); } } while (0)
    DN2_DMA(0); DN2_DMA(1); DN2_DMA(2);
#pragma unroll 1
    for (int k = 0; k < 128; ++k) {
      asm volatile("s_waitcnt vmcnt(16)" ::: "memory");
      __builtin_amdgcn_s_barrier();
      const int nx = k + 3 < 128 ? k + 3 : 127;
      { const bf16_t* src = AC + (u0 + 8 * (size_t)nx) * 16384; const unsigned sb = (unsigned)((k + 3) & 3) * 32768u;
#pragma unroll
        for (int m = 0; m < 8; ++m) { const int ch = lw * 64 + lane + 256 * m, row = ch >> 4, c16 = ch & 15;
          __builtin_amdgcn_global_load_lds((const unsigned*)(src + row * 128 + ((c16 ^ (row & 15)) << 3)), (LAS unsigned*)(F.lds + sb + lw * 1024 + m * 4096), 16, 0, 0); } }
    }
    asm volatile("s_waitcnt vmcnt(0)" ::: "memory");
#undef DN2_DMA
  } else if (wave >= 2) {
#pragma unroll 1
    for (int k = 0; k < 128; ++k) __builtin_amdgcn_s_barrier();
  } else {
    const int col = quarter * 32 + wave * 16 + cc;
    f32x4 S[8];
#pragma unroll
    for (int r = 0; r < 8; ++r) S[r] = (f32x4){0.f, 0.f, 0.f, 0.f};
    u32x2 bb[4][8];
#pragma unroll
    for (int p = 0; p < 3; ++p)
#pragma unroll
      for (int r = 0; r < 8; ++r) bb[p][r] = *(const u32x2*)(BCT + (u0 + 8 * (size_t)p) * 16384 + col * 128 + 16 * r + 4 * q);
#pragma unroll 1
    for (int k4 = 0; k4 < 128; k4 += 4) {
#pragma unroll
      for (int kk = 0; kk < 4; ++kk) {
        const int k = k4 + kk;
        __builtin_amdgcn_s_barrier();
        const size_t u = u0 + 8 * (size_t)k, un = u0 + 8 * (size_t)(k + 3 < 128 ? k + 3 : 127);
#pragma unroll
        for (int r = 0; r < 8; ++r) bb[(kk + 3) & 3][r] = *(const u32x2*)(BCT + un * 16384 + col * 128 + 16 * r + 4 * q);
        const LAS unsigned char* slot = F.lds + (unsigned)(k & 3) * 32768u;
        u32x2 sp[8]; bf16x8 bfr[4];
#pragma unroll
        for (int r = 0; r < 8; ++r) sp[r] = pack4(S[r]);
#pragma unroll
        for (int kb = 0; kb < 4; ++kb) { u32x4 bw; bw.x = sp[2 * kb].x; bw.y = sp[2 * kb].y; bw.z = sp[2 * kb + 1].x; bw.w = sp[2 * kb + 1].y; bfr[kb] = __builtin_bit_cast(bf16x8, bw); }
        f32x4 Sn[8];
#pragma unroll
        for (int qt = 0; qt < 4; ++qt) {
          bf16x8 af[2][4];
#pragma unroll
          for (int r = 0; r < 2; ++r)
#pragma unroll
            for (int kb = 0; kb < 4; ++kb) af[r][kb] = *(const LAS bf16x8*)(slot + (16 * (2 * qt + r) + cc) * 256 + (((4 * kb + q) ^ cc) << 4));
#pragma unroll
          for (int r = 0; r < 2; ++r) {
            f32x4 a = {0.f, 0.f, 0.f, 0.f};
#pragma unroll
            for (int kb = 0; kb < 4; ++kb) a = mfma16(af[r][kb], bfr[kb], a);
            Sn[2 * qt + r] = a;
          }
        }
#pragma unroll
        for (int r = 0; r < 8; ++r) { *(u32x2*)(BCT + u * 16384 + col * 128 + 16 * r + 4 * q) = sp[r]; S[r] = Sn[r] + unpack4(bb[kk][r]); }
      }
    }
  }
}

__device__ __forceinline__ void ph_dn3(Frame& F, const Args& A) {
  const int lane = F.lane, q = lane >> 4, cc = lane & 15, tt = F.wave & 3;
  const bf16_t* ST = (const bf16_t*)(F.ws + WS_BCT); const bf16_t* QH = (const bf16_t*)(F.ws + WS_QH); const bf16_t* OL = (const bf16_t*)(F.ws + WS_OLOC);
  const bf16_t* P = (const bf16_t*)(F.ws + WS_P); bf16_t* Y = (bf16_t*)(F.ws + WS_Y); const float* gn = A.in[22];
  for (int up = F.bid; up < 1024; up += F.G) {
    const int u = up * 2 + (F.wave >> 2), h = u & 7, c = (u >> 3) & 127, b = u >> 10;
    const size_t t = (size_t)b * S_ + c * 64 + tt * 16 + cc;
    bf16x8 bq[4];
#pragma unroll
    for (int kb = 0; kb < 4; ++kb) bq[kb] = *(const bf16x8*)(QH + (size_t)u * 8192 + (tt * 16 + cc) * 128 + kb * 32 + q * 8);
    f32x4 acc[8]; float ss = 0.f;
    u32x2 olv[8], zv[8]; bf16x8 af[8][4];
#pragma unroll
    for (int td = 0; td < 8; ++td) {
      olv[td] = *(const u32x2*)(OL + t * D_ + h * 128 + td * 16 + 4 * q); zv[td] = *(const u32x2*)(P + t * LDP1 + 3072 + h * 128 + td * 16 + 4 * q);
#pragma unroll
      for (int kb = 0; kb < 4; ++kb) af[td][kb] = *(const bf16x8*)(ST + (size_t)u * 16384 + (td * 16 + cc) * 128 + kb * 32 + q * 8);
    }
#pragma unroll
    for (int td = 0; td < 8; ++td) {
      acc[td] = unpack4(olv[td]);
#pragma unroll
      for (int kb = 0; kb < 4; ++kb) acc[td] = mfma16(af[td][kb], bq[kb], acc[td]);
#pragma unroll
      for (int r = 0; r < 4; ++r) ss += acc[td][r] * acc[td][r];
    }
    ss += __shfl_xor(ss, 16); ss += __shfl_xor(ss, 32);
    const float rstd = rsqrtf(ss * (1.f / 128.f) + EPS);
#pragma unroll
    for (int td = 0; td < 8; ++td) {
      const f32x4 z = unpack4(zv[td]);
      const f32x4 g = *(const f32x4*)(gn + td * 16 + 4 * q);
      f32x4 y;
#pragma unroll
      for (int r = 0; r < 4; ++r) y[r] = acc[td][r] * rstd * g[r] * siluf_(z[r]);
      *(u32x2*)(Y + t * D_ + h * 128 + td * 16 + 4 * q) = pack4(y);
    }
  }
}


__device__ __forceinline__ void ph_mix0_a(Frame& F, const Args& A) {
  const bf16_t* P = (const bf16_t*)(F.ws + WS_P); const float* SK = (const float*)(F.ws + WS_SK);
  const int tid = F.tid, lane = F.lane, wave = F.wave, q = lane >> 4, cc = lane & 15;
  LAS bf16_t* XC = (LAS bf16_t*)F.lds;
  LAS float* PB = (LAS float*)(F.lds + 140 * 1024);
  for (int i = tid; i < 512; i += NTHR) { PB[i] = A.in[10][i]; PB[512 + i] = A.in[12][i]; PB[1024 + i] = softplusf_(-A.in[13][i]); }
  const bf16_t* WAT = (const bf16_t*)(F.ws + WS_GW); const bf16_t* WXT = WAT + 8 * 4096;
  for (int u = F.bid; u < 256; u += F.G) {
    const int b = u >> 7, c = u & 127, t0 = u * 64;
    __syncthreads();
    {
      const int cg = tid & 63, tr = tid >> 6, ch0 = cg * 8;
      float w[4][8], bias[8];
#pragma unroll
      for (int j = 0; j < 4; ++j) { const f32x4 a = *(const f32x4*)(A.in[7] + j * 512 + ch0), bq = *(const f32x4*)(A.in[7] + j * 512 + ch0 + 4);
        w[j][0] = a[0]; w[j][1] = a[1]; w[j][2] = a[2]; w[j][3] = a[3]; w[j][4] = bq[0]; w[j][5] = bq[1]; w[j][6] = bq[2]; w[j][7] = bq[3]; }
      { const f32x4 a = *(const f32x4*)(A.in[8] + ch0), bq = *(const f32x4*)(A.in[8] + ch0 + 4); bias[0] = a[0]; bias[1] = a[1]; bias[2] = a[2]; bias[3] = a[3]; bias[4] = bq[0]; bias[5] = bq[1]; bias[6] = bq[2]; bias[7] = bq[3]; }
      float win[3][8];
#pragma unroll
      for (int j = 0; j < 3; ++j) {
        const int tl = c * 64 + tr * 8 - 3 + j;
        u32x4 v = {0u, 0u, 0u, 0u};
        if (tl >= 0) v = *(const u32x4*)(P + (size_t)(b * S_ + tl) * LDP0 + ch0);
        win[j][0] = bf2f(v.x & 0xffffu); win[j][1] = bf2f(v.x >> 16); win[j][2] = bf2f(v.y & 0xffffu); win[j][3] = bf2f(v.y >> 16);
        win[j][4] = bf2f(v.z & 0xffffu); win[j][5] = bf2f(v.z >> 16); win[j][6] = bf2f(v.w & 0xffffu); win[j][7] = bf2f(v.w >> 16);
      }
#pragma unroll
      for (int k = 0; k < 8; ++k) {
        const int tok = tr * 8 + k;
        const u32x4 v = *(const u32x4*)(P + (size_t)(t0 + tok) * LDP0 + ch0);
        float cur[8] = {bf2f(v.x & 0xffffu), bf2f(v.x >> 16), bf2f(v.y & 0xffffu), bf2f(v.y >> 16), bf2f(v.z & 0xffffu), bf2f(v.z >> 16), bf2f(v.w & 0xffffu), bf2f(v.w >> 16)};
        float o[8];
#pragma unroll
        for (int i = 0; i < 8; ++i) o[i] = bias[i] + w[0][i] * win[0][i] + w[1][i] * win[1][i] + w[2][i] * win[2][i] + w[3][i] * cur[i];
        u32x4 pk; pk.x = pk2(o[0], o[1]); pk.y = pk2(o[2], o[3]); pk.z = pk2(o[4], o[5]); pk.w = pk2(o[6], o[7]);
        *(LAS u32x4*)(XC + tok * 520 + ch0) = pk;
#pragma unroll
        for (int i = 0; i < 8; ++i) { win[0][i] = win[1][i]; win[1][i] = win[2][i]; win[2][i] = cur[i]; }
      }
    }
    __syncthreads();
    {
      const int h = wave;
      float* HL = (float*)(F.ws + WS_HLOC); float* CPp = (float*)(F.ws + WS_CP);
#pragma unroll 1
      for (int tj = 0; tj < 4; ++tj) {
        bf16x8 fa[2], fx[2];
#pragma unroll
        for (int kb = 0; kb < 2; ++kb) { fa[kb] = *(const bf16x8*)(WAT + h * 4096 + (tj * 16 + cc) * 64 + kb * 32 + q * 8); fx[kb] = *(const bf16x8*)(WXT + h * 4096 + (tj * 16 + cc) * 64 + kb * 32 + q * 8); }
        const int ch = h * 64 + tj * 16 + 4 * q;
        const f32x4 vba = *(const LAS f32x4*)(PB + ch), vbx = *(const LAS f32x4*)(PB + 512 + ch), vsp = *(const LAS f32x4*)(PB + 1024 + ch);
        f32x4 carH = {0.f, 0.f, 0.f, 0.f}, carP = {1.f, 1.f, 1.f, 1.f};
#pragma unroll 1
        for (int tt = 0; tt < 4; ++tt) {
          const int tok = tt * 16 + cc;
          f32x4 ar = {0.f, 0.f, 0.f, 0.f}, ai = {0.f, 0.f, 0.f, 0.f};
#pragma unroll
          for (int kb = 0; kb < 2; ++kb) { const bf16x8 bx_ = *(const LAS bf16x8*)(XC + tok * 520 + h * 64 + kb * 32 + q * 8); ar = mfma16(fa[kb], bx_, ar); ai = mfma16(fx[kb], bx_, ai); }
          const u32x2 xv = *(const LAS u32x2*)(XC + tok * 520 + ch); const f32x4 xcv = unpack4(xv);
          f32x4 Aa, Bb;
#pragma unroll
          for (int r = 0; r < 4; ++r) {
            const float rg = sigmoidf_(ar[r] + vba[r]), ig = sigmoidf_(ai[r] + vbx[r]);
            const float la = -8.f * rg * vsp[r];
            Aa[r] = __expf(la); Bb[r] = sqrtf(-expm1f(2.f * la)) * (ig * xcv[r]);
          }
#pragma unroll
          for (int d = 1; d < 16; d <<= 1) {
#pragma unroll
            for (int r = 0; r < 4; ++r) { const float pa = __shfl_up(Aa[r], d, 16), pb = __shfl_up(Bb[r], d, 16); if (cc >= d) { Bb[r] = Aa[r] * pb + Bb[r]; Aa[r] = Aa[r] * pa; } }
          }
          f32x4 hl, cp;
#pragma unroll
          for (int r = 0; r < 4; ++r) { hl[r] = Bb[r] + Aa[r] * carH[r]; cp[r] = Aa[r] * carP[r]; }
          *(f32x4*)(HL + (size_t)(t0 + tok) * 512 + ch) = hl; *(f32x4*)(CPp + (size_t)(t0 + tok) * 512 + ch) = cp;
#pragma unroll
          for (int r = 0; r < 4; ++r) { carH[r] = __shfl(hl[r], 15, 16); carP[r] = __shfl(cp[r], 15, 16); }
        }
      }
    }
    LAS float* GC = (LAS float*)F.lds;
    LAS float* SEG = (LAS float*)(F.lds + 16640);
    LAS bf16_t* QT = (LAS bf16_t*)(F.lds + 18688);
    LAS bf16_t* KH = (LAS bf16_t*)(F.lds + 27904);
    LAS bf16_t* KTT = (LAS bf16_t*)(F.lds + 37120);
    LAS bf16_t* VT = (LAS bf16_t*)(F.lds + 46336);
    LAS bf16_t* ATT = (LAS bf16_t*)(F.lds + 64768);
#pragma unroll 1
    for (int hh = 0; hh < 4; ++hh) {
      const int ug = (b * 4 + hh) * 128 + c;
      __syncthreads();
      {
        const int tok = tid >> 3, dk0 = (tid & 7) * 8;
        float gl[16];
#pragma unroll
        for (int i = 0; i < 4; ++i) { const f32x4 v = *(const f32x4*)(SK + (size_t)(t0 + tok) * 16 + 4 * i); gl[4*i] = v[0]; gl[4*i+1] = v[1]; gl[4*i+2] = v[2]; gl[4*i+3] = v[3]; }
        float v[8];
        { const f32x4 b0 = *(const f32x4*)(A.in[15] + hh * 64 + dk0), b1 = *(const f32x4*)(A.in[15] + hh * 64 + dk0 + 4); v[0] = b0[0]; v[1] = b0[1]; v[2] = b0[2]; v[3] = b0[3]; v[4] = b1[0]; v[5] = b1[1]; v[6] = b1[2]; v[7] = b1[3]; }
#pragma unroll
        for (int r = 0; r < 16; ++r) { const f32x4 w0 = *(const f32x4*)(A.in[14] + r * 256 + hh * 64 + dk0), w1 = *(const f32x4*)(A.in[14] + r * 256 + hh * 64 + dk0 + 4);
          v[0] += gl[r] * w0[0]; v[1] += gl[r] * w0[1]; v[2] += gl[r] * w0[2]; v[3] += gl[r] * w0[3]; v[4] += gl[r] * w1[0]; v[5] += gl[r] * w1[1]; v[6] += gl[r] * w1[2]; v[7] += gl[r] * w1[3]; }
#pragma unroll
        for (int i = 0; i < 8; ++i) GC[tok * 65 + dk0 + i] = (fminf(v[i], 0.f) - log1pf(__expf(-fabsf(v[i])))) * (1.f / 16.f);
      }
      __syncthreads();
      float loc[8];
      { const int dk = tid & 63, sg = tid >> 6; float a = 0.f;
#pragma unroll
        for (int i = 0; i < 8; ++i) { a += GC[(sg * 8 + i) * 65 + dk]; loc[i] = a; }
        SEG[sg * 64 + dk] = a; }
      __syncthreads();
      { const int dk = tid & 63, sg = tid >> 6; float off = 0.f;
        for (int s2 = 0; s2 < sg; ++s2) off += SEG[s2 * 64 + dk];
#pragma unroll
        for (int i = 0; i < 8; ++i) GC[(sg * 8 + i) * 65 + dk] = loc[i] + off; }
      __syncthreads();
      {
        const int tok = tid >> 3, part = tid & 7, dk0 = part * 8;
        const u32x4 qv = *(const u32x4*)(P + (size_t)(t0 + tok) * LDP0 + 1024 + hh * 64 + dk0), kv = *(const u32x4*)(P + (size_t)(t0 + tok) * LDP0 + 1280 + hh * 64 + dk0);
        const unsigned qq[4] = {qv.x, qv.y, qv.z, qv.w}, kk[4] = {kv.x, kv.y, kv.z, kv.w};
        float qt[8], kh[8];
#pragma unroll
        for (int i = 0; i < 8; ++i) {
          const float g = GC[tok * 65 + dk0 + i], gl_ = GC[63 * 65 + dk0 + i];
          const float qf = bf2f((i & 1) ? (qq[i >> 1] >> 16) : (qq[i >> 1] & 0xffffu)), kf = bf2f((i & 1) ? (kk[i >> 1] >> 16) : (kk[i >> 1] & 0xffffu));
          qt[i] = qf * __expf(g) * 0.125f; kh[i] = kf * __expf(-g);
          KTT[(dk0 + i) * 72 + tok] = (bf16_t)f2bf(kf * __expf(gl_ - g));
        }
        u32x4 o; o.x = pk2(qt[0], qt[1]); o.y = pk2(qt[2], qt[3]); o.z = pk2(qt[4], qt[5]); o.w = pk2(qt[6], qt[7]);
        *(LAS u32x4*)(QT + tok * 72 + dk0) = o; *(u32x4*)((bf16_t*)(F.ws + WS_QG) + (size_t)(t0 + tok) * 256 + hh * 64 + dk0) = o;
        o.x = pk2(kh[0], kh[1]); o.y = pk2(kh[2], kh[3]); o.z = pk2(kh[4], kh[5]); o.w = pk2(kh[6], kh[7]);
        *(LAS u32x4*)(KH + tok * 72 + dk0) = o;
        const bf16_t* vsrc = P + (size_t)(t0 + tok) * LDP0 + 1536 + hh * 128 + part * 16;
        const u32x4 v0 = *(const u32x4*)vsrc, v1 = *(const u32x4*)(vsrc + 8);
        const unsigned vv[8] = {v0.x, v0.y, v0.z, v0.w, v1.x, v1.y, v1.z, v1.w};
#pragma unroll
        for (int i = 0; i < 8; ++i) { VT[(part * 16 + 2 * i) * 72 + tok] = (bf16_t)(vv[i] & 0xffffu); VT[(part * 16 + 2 * i + 1) * 72 + tok] = (bf16_t)(vv[i] >> 16); }
        if (tid < 64) ((float*)(F.ws + WS_DEC))[(size_t)ug * 64 + tid] = __expf(GC[63 * 65 + tid]);
      }
      __syncthreads();
#pragma unroll 1
      for (int m = 0; m < 2; ++m) {
        const int id = wave * 2 + m, ti = id >> 2, tj = id & 3;
        f32x4 acc = {0.f, 0.f, 0.f, 0.f};
        if (tj <= ti) acc = mma_tile<64>(QT + ti * 16 * 72, 72, KH + tj * 16 * 72, 72, lane, acc);
#pragma unroll
        for (int r = 0; r < 4; ++r) { const int i = ti * 16 + 4 * q + r, j = tj * 16 + cc; ATT[i * 72 + j] = (bf16_t)f2bf(i >= j ? acc[r] : 0.f); }
      }
      __syncthreads();
#pragma unroll 1
      for (int m = 0; m < 8; ++m) {
        const int id = wave + 8 * m;
        f32x4 acc = {0.f, 0.f, 0.f, 0.f};
        if (id < 32) {
          const int tdv = id >> 2, tt = id & 3;
          acc = mma_tile<64>(VT + tdv * 16 * 72, 72, ATT + tt * 16 * 72, 72, lane, acc);
          *(u32x2*)((bf16_t*)(F.ws + WS_OLG) + (size_t)(t0 + tt * 16 + cc) * 512 + hh * 128 + tdv * 16 + 4 * q) = pack4(acc);
        } else {
          const int tdk = (id - 32) >> 3, tdv = id & 7;
          acc = mma_tile<64>(KTT + tdk * 16 * 72, 72, VT + tdv * 16 * 72, 72, lane, acc);
          *(f32x4*)((float*)(F.ws + WS_DST) + (size_t)ug * 8192 + (tdv * 16 + cc) * 64 + tdk * 16 + 4 * q) = acc;
        }
      }
    }
  }
}
__device__ __forceinline__ void ph_mix0_b(Frame& F) {
  if (F.bid < 128) {
    const int gidx = F.bid * NTHR + F.tid, bh = gidx >> 13, e = gidx & 8191, dk = e & 63;
    const float* DST = (const float*)(F.ws + WS_DST) + (size_t)bh * 128 * 8192 + e; bf16_t* STG = (bf16_t*)(F.ws + WS_STG) + (size_t)bh * 128 * 8192 + e;
    const float* DEC = (const float*)(F.ws + WS_DEC) + (size_t)bh * 128 * 64 + dk;
    float S = 0.f;
#pragma unroll 8
    for (int c = 0; c < 128; ++c) { const float d = DEC[c * 64], ds = DST[(size_t)c * 8192]; STG[(size_t)c * 8192] = (bf16_t)f2bf(S); S = d * S + ds; }
  } else if (F.bid < 130) {
    const int idx = (F.bid - 128) * NTHR + F.tid, b = idx >> 9, ch = idx & 511;
    const float* HL = (const float*)(F.ws + WS_HLOC); const float* CPp = (const float*)(F.ws + WS_CP); float* CAR = (float*)(F.ws + WS_CAR);
    float carry = 0.f;
#pragma unroll 8
    for (int c = 0; c < 128; ++c) { const size_t t = (size_t)b * S_ + c * 64 + 63; const float a = CPp[t * 512 + ch], hb = HL[t * 512 + ch]; CAR[(size_t)(b * 128 + c) * 512 + ch] = carry; carry = a * carry + hb; }
  }
}
__device__ __forceinline__ void ph_mix0_c(Frame& F, const Args& A) {
  const bf16_t* P = (const bf16_t*)(F.ws + WS_P); bf16_t* Y = (bf16_t*)(F.ws + WS_Y);
  const int tid = F.tid, lane = F.lane, wave = F.wave, q = lane >> 4, cc = lane & 15;
  for (int u = F.bid; u < 256; u += F.G) {
    const int b = u >> 7, c = u & 127, t0 = u * 64;
    {
      const int tok = tid >> 3, part = tid & 7; const size_t t = (size_t)t0 + tok;
      const float* HL = (const float*)(F.ws + WS_HLOC) + t * 512; const float* CPp = (const float*)(F.ws + WS_CP) + t * 512; const float* CAR = (const float*)(F.ws + WS_CAR) + (size_t)u * 512;
#pragma unroll 4
      for (int k = 0; k < 16; ++k) {
        const int ch = k * 32 + part * 4;
        const f32x4 hl = *(const f32x4*)(HL + ch), cp = *(const f32x4*)(CPp + ch), ca = *(const f32x4*)(CAR + ch);
        const f32x4 ga = unpack4(*(const u32x2*)(P + t * LDP0 + 512 + ch));
        f32x4 y;
#pragma unroll
        for (int r = 0; r < 4; ++r) y[r] = gelu_tanh(ga[r]) * (hl[r] + cp[r] * ca[r]);
        *(u32x2*)(Y + t * D_ + ch) = pack4(y);
      }
    }
    {
      const int hh = wave >> 1, ug = (b * 4 + hh) * 128 + c;
      const bf16_t* STG = (const bf16_t*)(F.ws + WS_STG) + (size_t)ug * 8192; const bf16_t* QG = (const bf16_t*)(F.ws + WS_QG); const bf16_t* OLG = (const bf16_t*)(F.ws + WS_OLG);
#pragma unroll 1
      for (int m = 0; m < 2; ++m) {
        const int tt = (wave & 1) * 2 + m; const size_t t = (size_t)t0 + tt * 16 + cc;
        bf16x8 bq[2];
#pragma unroll
        for (int kb = 0; kb < 2; ++kb) bq[kb] = *(const bf16x8*)(QG + t * 256 + hh * 64 + kb * 32 + q * 8);
        f32x4 acc[8]; float ss = 0.f;
        u32x2 olv[8], ogv[8]; bf16x8 af[8][2];
#pragma unroll
        for (int td = 0; td < 8; ++td) {
          olv[td] = *(const u32x2*)(OLG + t * 512 + hh * 128 + td * 16 + 4 * q); ogv[td] = *(const u32x2*)(P + t * LDP0 + 2048 + hh * 128 + td * 16 + 4 * q);
#pragma unroll
          for (int kb = 0; kb < 2; ++kb) af[td][kb] = *(const bf16x8*)(STG + (td * 16 + cc) * 64 + kb * 32 + q * 8);
        }
#pragma unroll
        for (int td = 0; td < 8; ++td) {
          acc[td] = unpack4(olv[td]);
#pragma unroll
          for (int kb = 0; kb < 2; ++kb) acc[td] = mfma16(af[td][kb], bq[kb], acc[td]);
#pragma unroll
          for (int r = 0; r < 4; ++r) ss += acc[td][r] * acc[td][r];
        }
        ss += __shfl_xor(ss, 16); ss += __shfl_xor(ss, 32);
        const float rstd = rsqrtf(ss * (1.f / 128.f) + EPS);
#pragma unroll
        for (int td = 0; td < 8; ++td) {
          const f32x4 og = unpack4(ogv[td]);
          const f32x4 g = *(const f32x4*)(A.in[16] + td * 16 + 4 * q);
          f32x4 y;
#pragma unroll
          for (int r = 0; r < 4; ++r) y[r] = acc[td][r] * rstd * g[r] * siluf_(og[r]);
          *(u32x2*)(Y + t * D_ + 512 + hh * 128 + td * 16 + 4 * q) = pack4(y);
        }
      }
    }
  }
}


#define XB_TMO      128
#define XB_XCNT(j)  (256  + 64 * (j))
#define XB_XSUB(j)  (1280 + 64 * (j))
#define XB_XGEN(j)  (2304 + 64 * (j))
#define XB_TOP      3328
#define XB_TOPGEN   3392
#define XCD_BAR_WORDS 3456
#define XB_SPIN_CAP (1u << 18)
__device__ __forceinline__ unsigned xb_ld(unsigned* p)              { return __hip_atomic_load(p, __ATOMIC_RELAXED, __HIP_MEMORY_SCOPE_AGENT); }
__device__ __forceinline__ unsigned xb_add(unsigned* p, unsigned v) { return __hip_atomic_fetch_add(p, v, __ATOMIC_RELAXED, __HIP_MEMORY_SCOPE_AGENT); }
__device__ __forceinline__ unsigned xb_xcc_id() { return (unsigned)__builtin_amdgcn_s_getreg((3 << 11) | 20) & 0xFu; }
#define XB_SPIN(cond, bar) do { unsigned _sp = 0; while (cond) { __builtin_amdgcn_s_sleep(1); \
    if ((++_sp & 255u) == 0u) { if (xb_ld(&(bar)[XB_TMO])) break; if (_sp > XB_SPIN_CAP) { atomicAdd(&(bar)[XB_TMO], 1u); break; } } } } while (0)
struct XcdBarrier { unsigned* bar; unsigned x; volatile LAS unsigned* st; };
__device__ __forceinline__ XcdBarrier xcd_barrier_post(unsigned* bar, volatile LAS unsigned* st) {
    XcdBarrier b; b.bar = bar; b.x = xb_xcc_id(); b.st = st;
    if (threadIdx.x == 0) (void)xb_add(&bar[XB_XCNT(b.x)], 1u);
    return b;
}
__device__ __forceinline__ void xcd_barrier_complete(unsigned* bar, unsigned x, unsigned& nloc, unsigned& nx) {
    const unsigned G = gridDim.x * gridDim.y * gridDim.z;
    unsigned sum, cnt, mine, sp = 0u;
    for (;;) {
        sum = 0u; cnt = 0u; mine = 0u;
#pragma unroll
        for (unsigned j = 0; j < 16; ++j) { const unsigned c = xb_ld(&bar[XB_XCNT(j)]); sum += c; cnt += (c > 0u) ? 1u : 0u; mine = (j == x) ? c : mine; }
        if (sum == G) break;
        __builtin_amdgcn_s_sleep(1);
        if ((++sp & 255u) == 0u) { if (xb_ld(&bar[XB_TMO])) break; if (sp > XB_SPIN_CAP) { atomicAdd(&bar[XB_TMO], 1u); break; } }
    }
    nloc = mine > 0u ? mine : 1u; nx = cnt > 0u ? cnt : 1u;
}
__device__ __forceinline__ void xcd_barrier(const XcdBarrier& b) {
    asm volatile("s_waitcnt vmcnt(0)" ::: "memory");
    __syncthreads();
    if (threadIdx.x == 0) {
        unsigned* bar = b.bar;
        __builtin_amdgcn_s_waitcnt(0);
        unsigned nloc = b.st[0], nx = b.st[1];
        if (nloc == 0u) { xcd_barrier_complete(bar, b.x, nloc, nx); b.st[0] = nloc; b.st[1] = nx; }
        const unsigned old = xb_add(&bar[XB_XSUB(b.x)], 1u);
        const unsigned gen = old / nloc;
        if (old + 1u == (gen + 1u) * nloc) {
            __builtin_amdgcn_fence(__ATOMIC_RELEASE, "agent");
            asm volatile("s_waitcnt vmcnt(0)" ::: "memory");
            const unsigned og = xb_add(&bar[XB_TOP], 1u);
            const unsigned tg = og / nx;
            if (og + 1u == (tg + 1u) * nx) xb_add(&bar[XB_TOPGEN], 1u);
            else XB_SPIN(xb_ld(&bar[XB_TOPGEN]) == tg, bar);
            __builtin_amdgcn_fence(__ATOMIC_ACQUIRE, "agent");
            xb_add(&bar[XB_XGEN(b.x)], 1u);
            asm volatile("s_waitcnt vmcnt(0)" ::: "memory");
        } else {
            XB_SPIN(xb_ld(&bar[XB_XGEN(b.x)]) == gen, bar);
            __builtin_amdgcn_fence(__ATOMIC_ACQUIRE, "agent");
            asm volatile("s_waitcnt vmcnt(0)" ::: "memory");
        }
    }
    __syncthreads();
}

enum { PH_PRO = 0, PH_N1_0, PH_GIN_0, PH_MIXA_0, PH_MIXB_0, PH_MIXC_0, PH_GOUT_0, PH_N2_0, PH_MOE1_0, PH_MOE2_0, PH_N1_1, PH_GIN_1, PH_MIXA_1, PH_MIXB_1, PH_MIXC_1, PH_GOUT_1, PH_N2_1, PH_MOE1_1, PH_MOE2_1, PH_FINAL, PH_COUNT };

constexpr unsigned DUP_MASK = 0u;
#define SEAM(k) do { if ((k) == PH_N1_0) grid.sync(); else xcd_barrier(xb); } while (0)
#define PHASE(k, ...) do { if (lo <= (k) && (k) < hi) { if ((k) != lo) SEAM(k); { __VA_ARGS__ } if ((DUP_MASK >> (k)) & 1u) { xcd_barrier(xb); { __VA_ARGS__ } } } } while (0)
template <int L>
__device__ __forceinline__ void layer_phases(Frame& F, const Args& args, cg::grid_group& grid, const XcdBarrier& xb, int lo, int hi, LAS int* tb, LAS int* cn) {
  constexpr int B = L * (PH_N1_1 - PH_N1_0);
  PHASE(B + PH_N1_0, if (L == 0) ph_norm<0>(F, args, 0); else ph_norm<1>(F, args, 1););
  PHASE(B + PH_GIN_0,
    pg8::StaticOrder S; S.init(T_, L == 0 ? LDP0 : LDP1, D_, F.G, F.bid);
    pg8::EpiBf16 E{(bf16_t*)(F.ws + WS_P), L == 0 ? LDP0 : LDP1};
    pg8::gemm_phase<pg8::EpiBf16, pg8::StaticOrder, true>(F.lds, (const bf16_t*)(F.ws + WS_XN), (const bf16_t*)(F.ws + (L == 0 ? WS_WIN0 : WS_WIN1)), D_, S, E);
  );
  if (L == 0) {
    PHASE(PH_MIXA_0, ph_mix0_a(F, args););
    PHASE(PH_MIXB_0, ph_mix0_b(F););
    PHASE(PH_MIXC_0, ph_mix0_c(F, args););
  }
  if (L == 1) {
    PHASE(PH_MIXA_1, ph_dn1(F, args););
    PHASE(PH_MIXB_1, ph_dn2(F, args););
    PHASE(PH_MIXC_1, ph_dn3(F, args););
  }
  PHASE(B + PH_GOUT_0,
    pg8::StaticOrder S; S.init(T_, D_, D_, F.G, F.bid);
    pg8::EpiResGate E{L == 0 ? args.in[0] : F.out, F.out, (const float*)(F.ws + WS_MOD) + L * 2 * 6144 + 2 * 1024};
    pg8::gemm_phase<pg8::EpiResGate, pg8::StaticOrder, false>(F.lds, (const bf16_t*)(F.ws + WS_Y), (const bf16_t*)(F.ws + (L == 0 ? WS_WOUT0 : WS_WOUT1)), D_, S, E);
  );
  PHASE(B + PH_N2_0, ph_norm<2>(F, args, L););
  PHASE(B + PH_MOE1_0,
    moe_tables(F, L, tb, cn);
    MoeSched<true> S{tb, cn, (const int*)(F.ws + WS_LIST), F.G, F.bid, D_, tb[32]};
    pg8::EpiSwiglu E{(bf16_t*)(F.ws + WS_HMID)};
    pg8::gemm_phase<pg8::EpiSwiglu, MoeSched<true>, true>(F.lds, (const bf16_t*)(F.ws + WS_XN), (const bf16_t*)(F.ws + WS_W13), D_, S, E);
  );
  PHASE(B + PH_MOE2_0,
    moe_tables(F, L, tb, cn);
    MoeSched<false> S{tb, cn, (const int*)(F.ws + WS_LIST), F.G, F.bid, 512, tb[32]};
    pg8::EpiBf16 E{(bf16_t*)(F.ws + WS_YB), D_};
    pg8::gemm_phase<pg8::EpiBf16, MoeSched<false>, true>(F.lds, (const bf16_t*)(F.ws + WS_HMID), (const bf16_t*)(F.ws + WS_W2), 512, S, E);
  );
}

__global__ void __launch_bounds__(NTHR, 2) k_fwd(Args args) {
  extern __shared__ __attribute__((aligned(16))) unsigned char lds_raw[];
  cg::grid_group grid = cg::this_grid();
  Frame F;
  F.lds = (LAS unsigned char*)lds_raw;
  F.tid = threadIdx.x; F.lane = F.tid & 63; F.wave = __builtin_amdgcn_readfirstlane(F.tid >> 6);
  F.G = gridDim.x; F.bid = blockIdx.x;
  F.out = args.out; F.ws = args.ws;
  LAS int* tb = (LAS int*)(F.lds + 132 * 1024); LAS int* cn = tb + 40;
  const int lo = args.ph_lo, hi = args.ph_hi;
  volatile LAS unsigned* xst = (volatile LAS unsigned*)(F.lds + LDS_BYTES - 16);
  if (F.tid < 4) xst[F.tid] = 0u;
  __syncthreads();
  const XcdBarrier xb = xcd_barrier_post((unsigned*)(F.ws + WS_CTL + 16384), xst);
  PHASE(PH_PRO, ph_prologue(F, args); convert_moe(F, args, 0, 0, F.G););
  layer_phases<0>(F, args, grid, xb, lo, hi, tb, cn);
  layer_phases<1>(F, args, grid, xb, lo, hi, tb, cn);
  PHASE(PH_FINAL, ph_norm<3>(F, args, 1););
}

__device__ __forceinline__ float ldb(const bf16_t* p, size_t i) { return bf2f(p[i]); }
__global__ __launch_bounds__(512) void k_rg_gates(const bf16_t* P, const float* conv_w, const float* conv_b, const float* wa, const float* ba, const float* wx, const float* bx, const float* lam, float* Aout, float* Bout) {
  __shared__ float xc[512];
  int t = blockIdx.x, ch = threadIdx.x, tl = t % S_;
  float v = conv_b[ch];
#pragma unroll
  for (int j = 0; j < 4; ++j) { int tt = tl - 3 + j; if (tt >= 0) v += conv_w[j * 512 + ch] * ldb(P, (size_t)(t - 3 + j) * LDP0 + ch); }
  xc[ch] = v;
  __syncthreads();
  int h = ch >> 6, jj = ch & 63;
  float r = ba[ch], ii = bx[ch];
  const float* wap = wa + h * 4096 + jj; const float* wxp = wx + h * 4096 + jj;
  for (int i = 0; i < 64; ++i) { float x = xc[h * 64 + i]; r += x * wap[i * 64]; ii += x * wxp[i * 64]; }
  r = sigmoidf_(r); ii = sigmoidf_(ii);
  float log_a = -8.f * r * softplusf_(-lam[ch]);
  float a = __expf(log_a);
  float bb = sqrtf(-expm1f(2.f * log_a)) * (ii * v);
  Aout[(size_t)t * 512 + ch] = a; Bout[(size_t)t * 512 + ch] = bb;
}
__global__ __launch_bounds__(64) void k_rg_scan(const float* Ain, const float* Bin, const bf16_t* P, bf16_t* Y) {
  int idx = blockIdx.x * 64 + threadIdx.x; int b = idx >> 9, ch = idx & 511;
  float h = 0.f;
  size_t t0 = (size_t)b * S_;
#pragma unroll 8
  for (int t = 0; t < S_; ++t) {
    float a = Ain[(t0 + t) * 512 + ch], bb = Bin[(t0 + t) * 512 + ch], ga = ldb(P, (t0 + t) * LDP0 + 512 + ch);
    h = a * h + bb;
    Y[(t0 + t) * D_ + ch] = (bf16_t)f2bf(gelu_tanh(ga) * h);
  }
}
__global__ __launch_bounds__(256) void k_gla_lg(const float* SK, const float* wg2, const float* bg2, float* LG) {
  int t = blockIdx.x, n = threadIdx.x;
  float v = bg2[n];
#pragma unroll
  for (int r = 0; r < 16; ++r) v += SK[(size_t)t * 16 + r] * wg2[r * 256 + n];
  float ls = fminf(v, 0.f) - log1pf(__expf(-fabsf(v)));
  LG[(size_t)t * 256 + n] = ls * (1.f / 16.f);
}
__global__ __launch_bounds__(128) void k_gla_rec(const bf16_t* P, const float* LG, float* O) {
  int b = blockIdx.x >> 2, h = blockIdx.x & 3, j = threadIdx.x;
  float s[64];
#pragma unroll
  for (int d = 0; d < 64; ++d) s[d] = 0.f;
  for (int t = 0; t < S_; ++t) {
    size_t row = (size_t)b * S_ + t;
    const bf16_t* q = P + row * LDP0 + 1024 + h * 64;
    const bf16_t* k = P + row * LDP0 + 1280 + h * 64;
    const float* lg = LG + row * 256 + h * 64;
    float v = ldb(P, row * LDP0 + 1536 + h * 128 + j);
    float o = 0.f;
#pragma unroll
    for (int d = 0; d < 64; ++d) { s[d] = __expf(lg[d]) * s[d] + bf2f(k[d]) * v; o += bf2f(q[d]) * s[d]; }
    O[row * 512 + h * 128 + j] = o * 0.125f;
  }
}
__global__ __launch_bounds__(256) void k_head_norm_gate(const float* O, int ldo, const float* g, const bf16_t* Pgate, int ldp, int gate_off, bf16_t* Y, int y_off, int nheads) {
  int w = blockIdx.x * 4 + (threadIdx.x >> 6), lane = threadIdx.x & 63;
  int t = w / nheads, h = w % nheads;
  float o0 = O[(size_t)t * ldo + h * 128 + lane], o1 = O[(size_t)t * ldo + h * 128 + 64 + lane];
  float ss = wave_sum(o0 * o0 + o1 * o1);
  float r = rsqrtf(ss * (1.f / 128.f) + EPS);
  float g0 = ldb(Pgate, (size_t)t * ldp + gate_off + h * 128 + lane), g1 = ldb(Pgate, (size_t)t * ldp + gate_off + h * 128 + 64 + lane);
  Y[(size_t)t * D_ + y_off + h * 128 + lane] = (bf16_t)f2bf(o0 * r * g[lane] * siluf_(g0));
  Y[(size_t)t * D_ + y_off + h * 128 + 64 + lane] = (bf16_t)f2bf(o1 * r * g[64 + lane] * siluf_(g1));
}
__global__ __launch_bounds__(256) void k_dn_prep(const bf16_t* P, const float* SK, const float* conv_w, const float* a_log, const float* dt_bias, float* QN, float* KN, float* V, float* BETA, float* G) {
  __shared__ float buf[3072];
  int t = blockIdx.x, tid = threadIdx.x, tl = t % S_;
  for (int c = tid; c < 3072; c += 256) {
    float v = 0.f;
#pragma unroll
    for (int j = 0; j < 4; ++j) { int tt = tl - 3 + j; if (tt >= 0) v += conv_w[j * 3072 + c] * ldb(P, (size_t)(t - 3 + j) * LDP1 + c); }
    buf[c] = siluf_(v);
  }
  __syncthreads();
  int w = tid >> 6, lane = tid & 63;
  for (int gi = w * 4; gi < w * 4 + 4; ++gi) {
    float x0 = buf[gi * 128 + lane], x1 = buf[gi * 128 + 64 + lane];
    float ss = wave_sum(x0 * x0 + x1 * x1);
    float sc = rsqrtf(ss + EPS);
    if (gi < 8) { sc *= 0.08838834764831845f; QN[(size_t)t * D_ + gi * 128 + lane] = x0 * sc; QN[(size_t)t * D_ + gi * 128 + 64 + lane] = x1 * sc; }
    else { int c = (gi - 8) * 128; KN[(size_t)t * D_ + c + lane] = x0 * sc; KN[(size_t)t * D_ + c + 64 + lane] = x1 * sc; }
  }
  for (int c = tid; c < 1024; c += 256) V[(size_t)t * D_ + c] = buf[2048 + c];
  if (tid < 8) {
    BETA[t * 8 + tid] = sigmoidf_(SK[(size_t)t * 16 + tid]);
    G[t * 8 + tid] = -__expf(a_log[tid]) * softplusf_(SK[(size_t)t * 16 + 8 + tid] + dt_bias[tid]);
  }
}
__global__ __launch_bounds__(128) void k_dn_rec(const float* QN, const float* KN, const float* V, const float* BETA, const float* G, float* O) {
  int b = blockIdx.x >> 3, h = blockIdx.x & 7, j = threadIdx.x;
  float s[128];
#pragma unroll
  for (int d = 0; d < 128; ++d) s[d] = 0.f;
  for (int t = 0; t < S_; ++t) {
    size_t row = (size_t)b * S_ + t;
    const float* q = QN + row * D_ + h * 128;
    const float* k = KN + row * D_ + h * 128;
    float v = V[row * D_ + h * 128 + j];
    float dec = __expf(G[row * 8 + h]), beta = BETA[row * 8 + h];
    float kd = 0.f;
#pragma unroll
    for (int d = 0; d < 128; ++d) { s[d] *= dec; kd += k[d] * s[d]; }
    float vn = beta * (v - kd);
    float o = 0.f;
#pragma unroll
    for (int d = 0; d < 128; ++d) { s[d] += k[d] * vn; o += q[d] * s[d]; }
    O[row * D_ + h * 128 + j] = o;
  }
}

extern "C" void kernel_launch(void* const* d_in, const int* in_sizes, int n_in, void* d_out, int out_size, void* d_ws, size_t ws_size, hipStream_t stream) {
  static int grid = 0;
  if (grid == 0) {
    if (n_in != 32 || ws_size < WS_END) { fprintf(stderr, "kernel_launch: bad inputs / workspace (%d inputs, ws %zu < %zu)\n", n_in, ws_size, (size_t)WS_END); grid = -1; return; }
    int dev = 0, cus = 0, per_cu = 0;
    hipGetDevice(&dev); hipDeviceGetAttribute(&cus, hipDeviceAttributeMultiprocessorCount, dev);
    if (hipFuncSetAttribute((const void*)k_fwd, hipFuncAttributeMaxDynamicSharedMemorySize, LDS_BYTES) != hipSuccess) { fprintf(stderr, "hipFuncSetAttribute failed\n"); grid = -1; return; }
    if (hipOccupancyMaxActiveBlocksPerMultiprocessor(&per_cu, (const void*)k_fwd, NTHR, LDS_BYTES) != hipSuccess || per_cu < 1) { fprintf(stderr, "occupancy query failed (%d)\n", per_cu); grid = -1; return; }
    grid = cus;
  }
  if (grid < 0) return;
  if (hipMemsetAsync((char*)d_ws + WS_CTL + 16384, 0, XCD_BAR_WORDS * 4, stream) != hipSuccess) { fprintf(stderr, "memset of barrier words failed\n"); return; }
  Args a{};
  for (int i = 0; i < 32; ++i) a.in[i] = (const float*)d_in[i];
  a.out = (float*)d_out; a.ws = (unsigned char*)d_ws;
  auto run = [&](int lo, int hi) {
    a.ph_lo = lo; a.ph_hi = hi; void* kargs[] = {&a};
    hipError_t e = hipLaunchCooperativeKernel((const void*)k_fwd, dim3(grid), dim3(NTHR), kargs, LDS_BYTES, stream);
    if (e != hipSuccess) fprintf(stderr, "cooperative launch failed: %s\n", hipGetErrorString(e));
  };
  unsigned char* ws = (unsigned char*)d_ws;
  const bf16_t* P = (const bf16_t*)(ws + WS_P); bf16_t* Y = (bf16_t*)(ws + WS_Y); const float* SK = (const float*)(ws + WS_SK);
  float* R0 = (float*)(ws + WS_SCR); float* R1 = R0 + (size_t)T_ * 1024; float* R3 = R1 + (size_t)T_ * 1024;
  float* R2 = (float*)(ws + WS_XN);
  const float* const* in = (const float* const*)d_in;
  run(PH_PRO, PH_COUNT);

}
```
